# Optimizing an MI355X kernel written in HIP

```python
import math
import jax, jax.numpy as jnp
from jax import lax
import numpy as np

D_MODEL = 2048
BATCH = 8
SEQ = 4096
DEPTH = 2

EPS = 1e-6
N_Q_HEADS_A = 12
N_KV_HEADS_A = 4
HEAD_DIM_A = 64
WINDOW = 128
BLOCK_A = 128
N_HEADS_B = 4
Q_LORA_B = 448
KV_LORA_B = 128
D_NOPE_B = 128
D_ROPE_B = 64
D_V_B = 128
ROPE_THETA = 10000.0
Q_BLOCK_B = 128
N_HEADS_C = 4
DQK_C = 96
DV_C = 192
CHUNK_C = 64
W_A = N_Q_HEADS_A * HEAD_DIM_A
W_B = N_HEADS_B * D_V_B
W_C = N_HEADS_C * DV_C
MIX_WIDTH = W_A + W_B + W_C
IN_SIZES = (N_Q_HEADS_A * HEAD_DIM_A, N_KV_HEADS_A * HEAD_DIM_A, N_KV_HEADS_A * HEAD_DIM_A,
            Q_LORA_B, KV_LORA_B, D_ROPE_B,
            N_HEADS_C * DQK_C, N_HEADS_C * DQK_C, N_HEADS_C * DV_C, 4 * N_HEADS_C, N_HEADS_C * DV_C)
IN_WIDTH = sum(IN_SIZES)
D_FF = -(-8 * D_MODEL // (3 * 256)) * 256

kernel_name = "hybrid_swa_mla_mlstm_encoder"


def _split_points(sizes):
    pts, acc = [], 0
    for s in sizes[:-1]:
        acc += s
        pts.append(acc)
    return pts


def rms_norm(x, g):
    xf = x.astype(jnp.float32)
    y = xf * lax.rsqrt(jnp.mean(xf * xf, axis=-1, keepdims=True) + EPS)
    return (y * g.astype(jnp.float32)).astype(x.dtype)


def alibi_slopes(n):
    def pow2(m):
        start = 2.0 ** (-8.0 / m)
        return [start ** (i + 1) for i in range(m)]
    if math.log2(n).is_integer():
        s = pow2(n)
    else:
        p = 2 ** math.floor(math.log2(n))
        s = pow2(p) + pow2(2 * p)[0::2][: n - p]
    return np.array(s, dtype=np.float32)


def rope_tables(positions):
    inv = 1.0 / (ROPE_THETA ** (jnp.arange(0, D_ROPE_B, 2, dtype=jnp.float32) / D_ROPE_B))
    ang = positions.astype(jnp.float32)[..., None] * inv
    return jnp.cos(ang), jnp.sin(ang)


def apply_rope(x, cos, sin):
    xf = x.astype(jnp.float32)
    x1, x2 = jnp.split(xf, 2, axis=-1)
    return jnp.concatenate([x1 * cos - x2 * sin, x1 * sin + x2 * cos], axis=-1).astype(x.dtype)


def window_attention(q, k, v, sinks):
    B, S, _ = q.shape
    nb = S // BLOCK_A
    G = N_Q_HEADS_A // N_KV_HEADS_A
    qb = q.reshape(B, nb, BLOCK_A, N_KV_HEADS_A, G, HEAD_DIM_A)
    pad = ((0, 0), (BLOCK_A, BLOCK_A), (0, 0))
    kp = jnp.pad(k, pad).reshape(B, nb + 2, BLOCK_A, N_KV_HEADS_A, HEAD_DIM_A)
    vp = jnp.pad(v, pad).reshape(B, nb + 2, BLOCK_A, N_KV_HEADS_A, HEAD_DIM_A)
    kb = jnp.concatenate([kp[:, :-2], kp[:, 1:-1], kp[:, 2:]], axis=2)
    vb = jnp.concatenate([vp[:, :-2], vp[:, 1:-1], vp[:, 2:]], axis=2)
    qpos = jnp.arange(S).reshape(nb, BLOCK_A)
    kpos = jnp.arange(-BLOCK_A, S + BLOCK_A).reshape(nb + 2, BLOCK_A)
    kpos = jnp.concatenate([kpos[:-2], kpos[1:-1], kpos[2:]], axis=1)
    dist = jnp.abs(qpos[:, :, None] - kpos[:, None, :])
    valid = (dist <= WINDOW) & (kpos[:, None, :] >= 0) & (kpos[:, None, :] < S)
    slopes = jnp.asarray(alibi_slopes(N_Q_HEADS_A)).reshape(N_KV_HEADS_A, G)
    bias = -slopes[None, :, :, None, None] * dist.astype(jnp.float32)[:, None, None, :, :]
    s = jnp.einsum('bnqhgd,bnkhd->bnhgqk', qb, kb, preferred_element_type=jnp.float32)
    s = jnp.where(valid[None, :, None, None], s * (HEAD_DIM_A ** -0.5) + bias[None], -jnp.inf)
    sink = sinks.astype(jnp.float32).reshape(N_KV_HEADS_A, G)[None, None, :, :, None]
    lse = jnp.logaddexp(jax.nn.logsumexp(s, axis=-1), sink)
    p = jnp.exp(s - lse[..., None])
    o = jnp.einsum('bnhgqk,bnkhd->bnqhgd', p.astype(v.dtype), vb)
    return o.reshape(B, S, W_A)


def mla_attention(c_q, c_kv, k_rope_in, q_norm_g, w_uq, kv_norm_g, w_ukv, cos, sin):
    B, S, _ = c_q.shape
    q = (rms_norm(c_q, q_norm_g) @ w_uq).reshape(B, S, N_HEADS_B, D_NOPE_B + D_ROPE_B)
    q_nope = q[..., :D_NOPE_B]
    q_rope = apply_rope(q[..., D_NOPE_B:], cos[:, :, None, :], sin[:, :, None, :])
    kv = (rms_norm(c_kv, kv_norm_g) @ w_ukv).reshape(B, S, N_HEADS_B, D_NOPE_B + D_V_B)
    k_nope, v = kv[..., :D_NOPE_B], kv[..., D_NOPE_B:]
    k_rope = apply_rope(k_rope_in, cos, sin)
    nb = S // Q_BLOCK_B
    qn = q_nope.reshape(B, nb, Q_BLOCK_B, N_HEADS_B, D_NOPE_B).transpose(1, 0, 2, 3, 4)
    qr = q_rope.reshape(B, nb, Q_BLOCK_B, N_HEADS_B, D_ROPE_B).transpose(1, 0, 2, 3, 4)
    scale = (D_NOPE_B + D_ROPE_B) ** -0.5

    def block(args):
        qn_b, qr_b = args
        s = (jnp.einsum('bqhd,bkhd->bhqk', qn_b, k_nope, preferred_element_type=jnp.float32)
             + jnp.einsum('bqhd,bkd->bhqk', qr_b, k_rope, preferred_element_type=jnp.float32)) * scale
        p = jax.nn.softmax(s, axis=-1)
        return jnp.einsum('bhqk,bkhd->bqhd', p.astype(v.dtype), v)

    o = lax.map(block, (qn, qr))
    return o.transpose(1, 0, 2, 3, 4).reshape(B, S, W_B)


def mlstm_direction(q, k, v, log_i, log_f):
    B, H, S, _ = q.shape
    nc, L = S // CHUNK_C, CHUNK_C
    qc = q.reshape(B, H, nc, L, DQK_C)
    kc = k.reshape(B, H, nc, L, DQK_C)
    vc = v.reshape(B, H, nc, L, DV_C)
    ic = log_i.reshape(B, H, nc, L)
    b = jnp.cumsum(log_f.reshape(B, H, nc, L), axis=-1)
    b_last = b[..., -1]
    tri = jnp.tril(jnp.ones((L, L), dtype=bool))
    dmat = jnp.where(tri, b[..., :, None] - b[..., None, :] + ic[..., None, :], -jnp.inf)
    a = b_last[..., None] - b + ic
    m_loc = jnp.max(a, axis=-1)
    w = jnp.exp(a - m_loc[..., None])
    C_loc = jnp.einsum('bhcl,bhcld,bhcle->bhcde', w, kc, vc)
    n_loc = jnp.einsum('bhcl,bhcld->bhcd', w, kc)

    def step(carry, inp):
        C, n, m = carry
        Cl, nl, ml, bl = inp
        m_new = jnp.maximum(bl + m, ml)
        sp = jnp.exp(bl + m - m_new)
        sl = jnp.exp(ml - m_new)
        C_new = sp[..., None, None] * C + sl[..., None, None] * Cl
        n_new = sp[..., None] * n + sl[..., None] * nl
        return (C_new, n_new, m_new), (C, n, m)

    init = (jnp.zeros((B, H, DQK_C, DV_C), jnp.float32), jnp.zeros((B, H, DQK_C), jnp.float32),
            jnp.full((B, H), -jnp.inf, jnp.float32))
    xs = (jnp.moveaxis(C_loc, 2, 0), jnp.moveaxis(n_loc, 2, 0),
          jnp.moveaxis(m_loc, 2, 0), jnp.moveaxis(b_last, 2, 0))
    _, (C_prev, n_prev, m_prev) = lax.scan(step, init, xs)
    C_prev = jnp.moveaxis(C_prev, 0, 2)
    n_prev = jnp.moveaxis(n_prev, 0, 2)
    m_prev = jnp.moveaxis(m_prev, 0, 2)
    inter_log = b + m_prev[..., None]
    m_t = jnp.maximum(inter_log, jnp.max(dmat, axis=-1))
    inter_w = jnp.exp(inter_log - m_t)
    qk = jnp.einsum('bhcld,bhcsd->bhcls', qc, kc) * jnp.exp(dmat - m_t[..., None])
    num = (inter_w[..., None] * jnp.einsum('bhcld,bhcde->bhcle', qc, C_prev)
           + jnp.einsum('bhcls,bhcse->bhcle', qk, vc))
    den = inter_w * jnp.einsum('bhcld,bhcd->bhcl', qc, n_prev) + jnp.sum(qk, axis=-1)
    h = num / jnp.maximum(jnp.abs(den), jnp.exp(-m_t))[..., None]
    return h.reshape(B, H, S, DV_C)


def mlstm_mixer(q, k, v, gates, o_pre, gate_b, head_g):
    B, S, _ = q.shape
    f32 = jnp.float32

    def heads(t, d):
        return t.astype(f32).reshape(B, S, N_HEADS_C, d).transpose(0, 2, 1, 3)

    qh = heads(q, DQK_C) * (DQK_C ** -0.5)
    kh = heads(k, DQK_C)
    vh = heads(v, DV_C)
    g = (gates.astype(f32) + gate_b.astype(f32)).reshape(B, S, 4, N_HEADS_C).transpose(2, 0, 3, 1)
    log_i_f, log_i_b = g[0], g[1]
    log_f_f, log_f_b = jax.nn.log_sigmoid(g[2]), jax.nn.log_sigmoid(g[3])
    h_f = mlstm_direction(qh, kh, vh, log_i_f, log_f_f)
    fl = lambda t: jnp.flip(t, axis=2)
    h_b = fl(mlstm_direction(fl(qh), fl(kh), fl(vh), fl(log_i_b), fl(log_f_b)))
    h = (h_f + h_b).transpose(0, 2, 1, 3)
    h = h * lax.rsqrt(jnp.mean(h * h, axis=-1, keepdims=True) + EPS)
    h = h * head_g.astype(f32).reshape(N_HEADS_C, DV_C)
    out = jax.nn.sigmoid(o_pre.astype(f32)) * h.reshape(B, S, W_C)
    return out.astype(q.dtype)


def setup_inputs(seed: int = 0) -> dict:
    key = jax.random.key(seed)
    ks = jax.random.split(key, 24)
    f32 = jnp.float32

    def dense(k, shape, fan_in, scale=1.0):
        return jax.random.normal(k, shape, f32) * (scale * fan_in ** -0.5)

    def gain(k, shape):
        return 1.0 + 0.05 * jax.random.normal(k, shape, f32)

    x = jax.random.normal(ks[0], (BATCH, SEQ, D_MODEL), f32)
    c = jax.random.normal(ks[1], (BATCH, D_MODEL), f32)
    offs = jax.random.randint(ks[2], (BATCH, 1), 0, 1024, dtype=jnp.int32)
    positions = offs + jnp.arange(SEQ, dtype=jnp.int32)[None, :]
    gate_b = jnp.concatenate([
        0.5 * jax.random.normal(ks[3], (DEPTH, 2 * N_HEADS_C), f32),
        3.0 + 3.0 * jax.random.uniform(ks[4], (DEPTH, 2 * N_HEADS_C), f32)], axis=-1)
    return {
        "x": x,
        "c": c,
        "positions": positions,
        "mod_w": dense(ks[5], (DEPTH, D_MODEL, 6 * D_MODEL), D_MODEL, 0.5),
        "mod_b": 0.02 * jax.random.normal(ks[6], (DEPTH, 6 * D_MODEL), f32),
        "pre_mix_g": gain(ks[7], (DEPTH, D_MODEL)),
        "post_mix_g": gain(ks[8], (DEPTH, D_MODEL)),
        "pre_ffn_g": gain(ks[9], (DEPTH, D_MODEL)),
        "post_ffn_g": gain(ks[10], (DEPTH, D_MODEL)),
        "w_in": dense(ks[11], (DEPTH, D_MODEL, IN_WIDTH), D_MODEL),
        "attn_sink": jax.random.normal(ks[12], (DEPTH, N_Q_HEADS_A), f32),
        "mla_q_norm_g": gain(ks[13], (DEPTH, Q_LORA_B)),
        "mla_w_uq": dense(ks[14], (DEPTH, Q_LORA_B, N_HEADS_B * (D_NOPE_B + D_ROPE_B)), Q_LORA_B),
        "mla_kv_norm_g": gain(ks[15], (DEPTH, KV_LORA_B)),
        "mla_w_ukv": dense(ks[16], (DEPTH, KV_LORA_B, N_HEADS_B * (D_NOPE_B + D_V_B)), KV_LORA_B),
        "mlstm_gate_b": gate_b,
        "mlstm_head_g": gain(ks[17], (DEPTH, W_C)),
        "w_out": dense(ks[18], (DEPTH, MIX_WIDTH, D_MODEL), MIX_WIDTH),
        "ffn_w_gate": dense(ks[19], (DEPTH, D_MODEL, D_FF), D_MODEL),
        "ffn_w_up": dense(ks[20], (DEPTH, D_MODEL, D_FF), D_MODEL),
        "ffn_w_down": dense(ks[21], (DEPTH, D_FF, D_MODEL), D_FF),
    }


def reference(x, c, positions, mod_w, mod_b, pre_mix_g, post_mix_g, pre_ffn_g, post_ffn_g,
              w_in, attn_sink, mla_q_norm_g, mla_w_uq, mla_kv_norm_g, mla_w_ukv,
              mlstm_gate_b, mlstm_head_g, w_out, ffn_w_gate, ffn_w_up, ffn_w_down):
    cos, sin = rope_tables(positions)
    split_pts = _split_points(IN_SIZES)
    for l in range(DEPTH):
        mod = jax.nn.silu(c) @ mod_w[l] + mod_b[l]
        shift1, scale1, gate1, shift2, scale2, gate2 = jnp.split(mod, 6, axis=-1)
        h = rms_norm(x, pre_mix_g[l]) * (1.0 + scale1[:, None, :]) + shift1[:, None, :]
        proj = h @ w_in[l]
        (aq, ak, av, bcq, bckv, bkr, cq, ck, cv, cg, co) = jnp.split(proj, split_pts, axis=-1)
        y_a = window_attention(aq, ak, av, attn_sink[l])
        y_b = mla_attention(bcq, bckv, bkr, mla_q_norm_g[l], mla_w_uq[l],
                            mla_kv_norm_g[l], mla_w_ukv[l], cos, sin)
        y_c = mlstm_mixer(cq, ck, cv, cg, co, mlstm_gate_b[l], mlstm_head_g[l])
        y = jnp.concatenate([y_a, y_b.astype(y_a.dtype), y_c.astype(y_a.dtype)], axis=-1) @ w_out[l]
        x = x + gate1[:, None, :] * rms_norm(y, post_mix_g[l])
        h = rms_norm(x, pre_ffn_g[l]) * (1.0 + scale2[:, None, :]) + shift2[:, None, :]
        f = (jax.nn.silu(h @ ffn_w_gate[l]) * (h @ ffn_w_up[l])) @ ffn_w_down[l]
        x = x + gate2[:, None, :] * rms_norm(f, post_ffn_g[l])
    return x
```

```cpp
#include <hip/hip_runtime.h>
#include <cstdio>
#include <cstdint>

constexpr int BATCH = 8, SEQ = 4096, DM = 2048, DEPTH = 2, M = BATCH * SEQ;
constexpr int NIN = 4240, NINP = 4352, DFF = 5632, NMOD = 6 * DM;
constexpr int C_AQ = 0, C_AK = 768, C_AV = 1024, C_BCQ = 1280, C_BCKV = 1728, C_BKR = 1856, C_CQ = 1920, C_CK = 2304, C_CV = 2688, C_CG = 3456, C_CO = 3472;
constexpr int QL = 448, QLP = 512, KVL = 128, NQB = 768, NKVB = 1024;
constexpr float EPS = 1e-6f;
constexpr float LOG2E = 1.4426950408889634f;
constexpr float QSCALE_A = 0.125f * 1.4426950408889634f;
constexpr float QSCALE_B = 0.10411754627697264f;
constexpr float QSCALE_C = 0.10206207261596575f;

namespace pg8 {
#define PG8_LAS __attribute__((address_space(3)))
typedef unsigned short bf16_t;
typedef short bf16x8 __attribute__((ext_vector_type(8)));
typedef float f32x4 __attribute__((ext_vector_type(4)));
typedef unsigned u32x4 __attribute__((ext_vector_type(4)));
constexpr int BM = 256, BK = 64, HALF = 128, HTB = HALF * BK * 2  , STAGE_BYTES = 8 * HTB, NXCD = 8, WGM = 8;

__host__ __device__ __forceinline__ int lds_byte(int r, int c) { const int st = (r >> 4) * 2 + (c >> 5), rr = r & 15, cc = c & 31, ob = rr * 64 + cc * 2; return st * 1024 + (ob ^ (((ob >> 9) & 1) << 5)); }
__host__ __device__ __forceinline__ void stage_rc(int b, int& R, int& C) { const int st = b / 1024, sb = b % 1024, swz = sb ^ (((sb >> 9) & 1) << 5); R = (st >> 1) * 16 + swz / 64; C = (st & 1) * 32 + (swz % 64) / 2; }
__host__ __device__ __forceinline__ int perm32(int rho) { const int n = rho >> 4, i = rho & 15; return 8 * (i >> 2) + 4 * n + (i & 3); }

struct Unit { int pm, pn; };
struct Gemm { const bf16_t* A; const bf16_t* Bt; int M, N, K, lda; };

struct StaticOrder {
    int nM, nN, nwg, G, c;
    __host__ __device__ void init(int M, int N, int G_, int c_) { nM = M / BM; nN = N / BM; nwg = nM * nN; G = G_; c = c_; }
    __host__ __device__ bool next(int i, Unit& u) const {
        const long L = (long)i * G + c; if (L >= nwg) return false;
        int wgid = (int)L; { const int q = nwg / NXCD, r = nwg % NXCD, xcd = wgid % NXCD, off = wgid / NXCD; wgid = (xcd < r ? xcd * (q + 1) : r * (q + 1) + (xcd - r) * q) + off; }
        const int nig = WGM * nN, gid = wgid / nig, fm = gid * WGM, gsz = (nM - fm) < WGM ? (nM - fm) : WGM;
        u.pm = fm + ((wgid % nig) % gsz); u.pn = (wgid % nig) / gsz; return true;
    }
    __device__ __forceinline__ void a_ready(const Unit&) const {}
    __device__ __forceinline__ void done(const Unit&) const {}
};


__device__ __forceinline__ unsigned cvt_pk_bf16(float lo, float hi) { unsigned r; asm volatile("v_cvt_pk_bf16_f32 %0, %1, %2" : "=v"(r) : "v"(lo), "v"(hi)); return r; }

struct EpiBf16 {
    static constexpr bool PERM = true, AFTER_DRAIN = false;
    bf16_t* O; int ldc;
    __device__ __forceinline__ void operator()(const f32x4 (&acc)[2][2][4][2], const Unit& u, int wr, int wc, int fr, int fq) const {
        const int row0 = u.pm * BM + wr * 64 + fr; const int col0 = u.pn * BM + wc * 32 + 8 * fq;
#pragma unroll
        for (int ai = 0; ai < 2; ++ai)
#pragma unroll
            for (int m = 0; m < 4; ++m) { unsigned off = (unsigned)(row0 + ai * HALF + m * 16) * (unsigned)ldc + (unsigned)col0; asm volatile("" : "+v"(off)); bf16_t* rowp = O + off;
#pragma unroll
                for (int bj = 0; bj < 2; ++bj) { const f32x4 v0 = acc[ai][bj][m][0], v1 = acc[ai][bj][m][1];
                    u32x4 w; w.x = cvt_pk_bf16(v0[0], v0[1]); w.y = cvt_pk_bf16(v0[2], v0[3]); w.z = cvt_pk_bf16(v1[0], v1[1]); w.w = cvt_pk_bf16(v1[2], v1[3]);
                    *(u32x4*)(rowp + bj * HALF) = w; } }
    }
};
struct EpiRowScale {
    static constexpr bool PERM = true, AFTER_DRAIN = false;
    bf16_t* O; int ldc; const float* rs; float mul;
    __device__ __forceinline__ void operator()(const f32x4 (&acc)[2][2][4][2], const Unit& u, int wr, int wc, int fr, int fq) const {
        const int row0 = u.pm * BM + wr * 64 + fr; const int col0 = u.pn * BM + wc * 32 + 8 * fq;
#pragma unroll
        for (int ai = 0; ai < 2; ++ai)
#pragma unroll
            for (int m = 0; m < 4; ++m) { int row = row0 + ai * HALF + m * 16; asm volatile("" : "+v"(row)); const float sc = rs[row] * mul; bf16_t* rowp = O + ((unsigned)row * (unsigned)ldc + (unsigned)col0);
#pragma unroll
                for (int bj = 0; bj < 2; ++bj) { const f32x4 v0 = acc[ai][bj][m][0] * sc, v1 = acc[ai][bj][m][1] * sc;
                    u32x4 w; w.x = cvt_pk_bf16(v0[0], v0[1]); w.y = cvt_pk_bf16(v0[2], v0[3]); w.z = cvt_pk_bf16(v1[0], v1[1]); w.w = cvt_pk_bf16(v1[2], v1[3]);
                    *(u32x4*)(rowp + bj * HALF) = w; } }
    }
};
struct EpiQRope {
    static constexpr bool PERM = true, AFTER_DRAIN = false;
    bf16_t* O; int ldc; const float* rs; float mul; const float* cs; const float* sn;
    __device__ __forceinline__ void operator()(const f32x4 (&acc)[2][2][4][2], const Unit& u, int wr, int wc, int fr, int fq) const {
        const int row0 = u.pm * BM + wr * 64 + fr; const int col0 = u.pn * BM + wc * 32 + 8 * fq;
#pragma unroll
        for (int ai = 0; ai < 2; ++ai)
#pragma unroll
            for (int m = 0; m < 4; ++m) { int row = row0 + ai * HALF + m * 16; asm volatile("" : "+v"(row)); const float sc = rs[row] * mul; bf16_t* rowp = O + ((unsigned)row * (unsigned)ldc + (unsigned)col0);
#pragma unroll
                for (int bj = 0; bj < 2; ++bj) { f32x4 v0 = acc[ai][bj][m][0] * sc, v1 = acc[ai][bj][m][1] * sc;
                    const int hc = (col0 + bj * HALF) % 192;
                    if (hc >= 128) { const int i0 = (hc - 128) >> 1; const f32x4 c = *(const f32x4*)(cs + (unsigned)(row * 32 + i0)), s = *(const f32x4*)(sn + (unsigned)(row * 32 + i0));
                        const f32x4 a = v0, b = v1;
                        v0[0] = a[0] * c[0] - a[1] * s[0]; v0[1] = a[0] * s[0] + a[1] * c[0]; v0[2] = a[2] * c[1] - a[3] * s[1]; v0[3] = a[2] * s[1] + a[3] * c[1];
                        v1[0] = b[0] * c[2] - b[1] * s[2]; v1[1] = b[0] * s[2] + b[1] * c[2]; v1[2] = b[2] * c[3] - b[3] * s[3]; v1[3] = b[2] * s[3] + b[3] * c[3]; }
                    u32x4 w; w.x = cvt_pk_bf16(v0[0], v0[1]); w.y = cvt_pk_bf16(v0[2], v0[3]); w.z = cvt_pk_bf16(v1[0], v1[1]); w.w = cvt_pk_bf16(v1[2], v1[3]);
                    *(u32x4*)(rowp + bj * HALF) = w; } }
    }
};
struct EpiSwiGLU {
    static constexpr bool PERM = true, AFTER_DRAIN = false;
    bf16_t* O; int ldc;
    __device__ __forceinline__ void operator()(const f32x4 (&acc)[2][2][4][2], const Unit& u, int wr, int wc, int fr, int fq) const {
        const int row0 = u.pm * BM + wr * 64 + fr; const int col0 = u.pn * HALF + wc * 32 + 8 * fq;
#pragma unroll
        for (int ai = 0; ai < 2; ++ai)
#pragma unroll
            for (int m = 0; m < 4; ++m) { unsigned off = (unsigned)(row0 + ai * HALF + m * 16) * (unsigned)ldc + (unsigned)col0; asm volatile("" : "+v"(off)); bf16_t* rowp = O + off;
                float o[8];
#pragma unroll
                for (int n = 0; n < 2; ++n)
#pragma unroll
                    for (int j = 0; j < 4; ++j) { const float g = acc[ai][0][m][n][j], up = acc[ai][1][m][n][j];
                        const float e = __builtin_amdgcn_exp2f(-g * 1.4426950408889634f); o[n * 4 + j] = g * __builtin_amdgcn_rcpf(1.0f + e) * up; }
                u32x4 w; w.x = cvt_pk_bf16(o[0], o[1]); w.y = cvt_pk_bf16(o[2], o[3]); w.z = cvt_pk_bf16(o[4], o[5]); w.w = cvt_pk_bf16(o[6], o[7]);
                *(u32x4*)rowp = w; }
    }
};

template <class Epi, class Sched, bool ALIGN_EPI = false, bool SP2 = false>
__device__ __forceinline__ void gemm_phase(PG8_LAS unsigned char* lds, const Gemm g, const Sched& S, const Epi& E, const int wave_id) {
    int lane_ = (int)__builtin_amdgcn_mbcnt_hi(~0u, __builtin_amdgcn_mbcnt_lo(~0u, 0u)); asm volatile("" : "+v"(lane_));
    const int wid = wave_id, lane = lane_, tid = wid * 64 + lane, wr = wid >> 2, wc = wid & 3, fr = lane & 15, fq = lane >> 4;
    const int K = g.K, nt = K / BK;
    unsigned voffA[2], voffB[2];
#pragma unroll
    for (int i = 0; i < 2; ++i) { int R, C; stage_rc(tid * 16 + i * 8192, R, C); const int Rb = Epi::PERM ? ((R & ~31) + perm32(R & 31)) : R;
        voffA[i] = (unsigned)(R * g.lda + C) * 2u; voffB[i] = (unsigned)(Rb * K + C) * 2u; }
    const size_t kstep = (size_t)(BK * 2);
    const size_t hstepA = (size_t)HALF * g.lda * 2, hstepB = (size_t)HALF * K * 2;
    const size_t tstepA = 2 * hstepA, tstepB = 2 * hstepB;
    const unsigned ldsw = (unsigned)wid * 1024u;
    const int aoff = lds_byte(wr * 64 + fr, fq * 8), boff = lds_byte(wc * 32 + fr, fq * 8);
#define PG8_SA(b, h) (((b) * 2 + (h)) * HTB)
#define PG8_SB(b, h) ((4 + (b) * 2 + (h)) * HTB)
#define PG8_STAGE(bufoff, gbase, voff) do { _Pragma("unroll") for (int _i = 0; _i < 2; ++_i) \
        __builtin_amdgcn_global_load_lds((const unsigned*)((const char*)(gbase) + (voff)[_i]), (PG8_LAS unsigned*)(lds + (bufoff) + ldsw + _i * 8192), 16, 0, 0); } while (0)
#define PG8_LDA(dst, b, h) do { _Pragma("unroll") for (int m = 0; m < 4; ++m) _Pragma("unroll") for (int k = 0; k < 2; ++k) dst[m][k] = *(const PG8_LAS bf16x8*)(lds + PG8_SA(b, h) + aoff + m * 2048 + k * 1024); } while (0)
#define PG8_LDB(dst, b, h) do { _Pragma("unroll") for (int n = 0; n < 2; ++n) _Pragma("unroll") for (int k = 0; k < 2; ++k) dst[n][k] = *(const PG8_LAS bf16x8*)(lds + PG8_SB(b, h) + boff + n * 2048 + k * 1024); } while (0)
#define PG8_MMA(ai, bj, At, Bt) do { __builtin_amdgcn_s_setprio(1); _Pragma("unroll") for (int m = 0; m < 4; ++m) _Pragma("unroll") for (int n = 0; n < 2; ++n) _Pragma("unroll") for (int k = 0; k < 2; ++k) \
        acc[ai][bj][m][n] = __builtin_amdgcn_mfma_f32_16x16x32_bf16(Bt[n][k], At[m][k], acc[ai][bj][m][n], 0, 0, 0); __builtin_amdgcn_s_setprio(0); } while (0)
#define PG8_WAIT_V(n) asm volatile("s_waitcnt vmcnt(" #n ")" ::: "memory")
#define PG8_WAIT_L(n) asm volatile("s_waitcnt lgkmcnt(" #n ")" ::: "memory")
#define PG8_BAR __builtin_amdgcn_s_barrier()
#define PG8_SCHED __builtin_amdgcn_sched_barrier(0)
    Unit cur, nxt; int ui = 0;
    if (!S.next(0, cur)) return;
    f32x4 acc[2][2][4][2];
#pragma unroll
    for (int a = 0; a < 2; ++a)
#pragma unroll
        for (int b = 0; b < 2; ++b)
#pragma unroll
            for (int m = 0; m < 4; ++m)
#pragma unroll
                for (int n = 0; n < 2; ++n) acc[a][b][m][n] = (f32x4){0.f, 0.f, 0.f, 0.f};
    bf16x8 At[4][2], B0[2][2], B1[2][2];
    const char* cA = (const char*)g.A + (size_t)cur.pm * tstepA; const char* cB = (const char*)g.Bt + (size_t)cur.pn * tstepB;
    S.a_ready(cur);
    if constexpr (SP2) {
        PG8_STAGE(PG8_SB(0, 0), cB, voffB); PG8_STAGE(PG8_SB(0, 1), cB + hstepB, voffB); PG8_STAGE(PG8_SA(0, 0), cA, voffA); PG8_STAGE(PG8_SA(0, 1), cA + hstepA, voffA);
        if (wr == 1) PG8_BAR;
        PG8_WAIT_V(2); PG8_BAR;
        PG8_STAGE(PG8_SB(1, 0), cB + kstep, voffB); PG8_STAGE(PG8_SA(1, 0), cA + kstep, voffA); PG8_STAGE(PG8_SB(1, 1), cB + hstepB + kstep, voffB);
        PG8_WAIT_V(6); PG8_BAR;
    } else {
        PG8_STAGE(PG8_SB(0, 0), cB, voffB); PG8_STAGE(PG8_SA(0, 0), cA, voffA); PG8_STAGE(PG8_SB(0, 1), cB + hstepB, voffB); PG8_STAGE(PG8_SA(0, 1), cA + hstepA, voffA);
        if (wr == 1) PG8_BAR;
        PG8_WAIT_V(4); PG8_BAR;
        PG8_STAGE(PG8_SB(1, 0), cB + kstep, voffB); PG8_STAGE(PG8_SA(1, 0), cA + kstep, voffA); PG8_STAGE(PG8_SB(1, 1), cB + hstepB + kstep, voffB);
        PG8_WAIT_V(6); PG8_BAR;
    }
    for (;;) {
        const bool has_next = S.next(ui + 1, nxt);
        const char* nA = has_next ? (const char*)g.A + (size_t)nxt.pm * tstepA : cA; const char* nB = has_next ? (const char*)g.Bt + (size_t)nxt.pn * tstepB : cB;
        for (int t = 0; t < nt; t += 2) {
            const bool last = (t == nt - 2);
            const char* a1 = cA + (size_t)(t + 1) * kstep;
            const char* a2 = last ? nA : cA + (size_t)(t + 2) * kstep; const char* b2 = last ? nB : cB + (size_t)(t + 2) * kstep;
            const char* a3 = a2 + kstep; const char* b3 = b2 + kstep;
            if (last && has_next) S.a_ready(nxt);
            if constexpr (SP2) {
            PG8_LDB(B0, 0, 0); PG8_LDB(B1, 0, 1); PG8_SCHED; PG8_LDA(At, 0, 0); PG8_STAGE(PG8_SA(1, 1), a1 + hstepA, voffA);
            PG8_WAIT_V(8); PG8_WAIT_L(0); PG8_BAR; PG8_MMA(0, 0, At, B0); PG8_MMA(0, 1, At, B1); PG8_BAR; PG8_SCHED;
            PG8_LDA(At, 0, 1); PG8_STAGE(PG8_SB(0, 0), b2, voffB); PG8_STAGE(PG8_SB(0, 1), b2 + hstepB, voffB); PG8_STAGE(PG8_SA(0, 0), a2, voffA);
            PG8_WAIT_V(8); PG8_WAIT_L(0); PG8_BAR; PG8_MMA(1, 0, At, B0); PG8_MMA(1, 1, At, B1); PG8_BAR; PG8_SCHED;
            PG8_LDB(B0, 1, 0); PG8_LDB(B1, 1, 1); PG8_SCHED; PG8_LDA(At, 1, 0); PG8_STAGE(PG8_SA(0, 1), a2 + hstepA, voffA);
            PG8_WAIT_V(8); PG8_WAIT_L(0); PG8_BAR; PG8_MMA(0, 0, At, B0); PG8_MMA(0, 1, At, B1); PG8_BAR; PG8_SCHED;
            PG8_LDA(At, 1, 1); PG8_STAGE(PG8_SB(1, 0), b3, voffB); PG8_STAGE(PG8_SB(1, 1), b3 + hstepB, voffB); PG8_STAGE(PG8_SA(1, 0), a3, voffA);
            PG8_WAIT_V(8); PG8_WAIT_L(0); PG8_BAR; PG8_MMA(1, 0, At, B0); PG8_MMA(1, 1, At, B1); PG8_BAR; PG8_SCHED;
            } else {
            PG8_LDB(B0, 0, 0); PG8_SCHED; PG8_LDA(At, 0, 0); PG8_STAGE(PG8_SA(1, 1), a1 + hstepA, voffA);
            PG8_WAIT_L(8); PG8_BAR; PG8_WAIT_L(0); PG8_MMA(0, 0, At, B0); PG8_BAR; PG8_SCHED;
            PG8_LDB(B1, 0, 1); PG8_STAGE(PG8_SB(0, 0), b2, voffB);
            PG8_BAR; PG8_WAIT_L(0); PG8_MMA(0, 1, At, B1); PG8_BAR;
            PG8_LDA(At, 0, 1); PG8_STAGE(PG8_SA(0, 0), a2, voffA);
            PG8_BAR; PG8_WAIT_L(0); PG8_MMA(1, 0, At, B0); PG8_BAR; PG8_SCHED;
            PG8_STAGE(PG8_SB(0, 1), b2 + hstepB, voffB);
            PG8_WAIT_V(6); PG8_BAR; PG8_MMA(1, 1, At, B1); PG8_BAR;
            PG8_LDB(B0, 1, 0); PG8_SCHED; PG8_LDA(At, 1, 0); PG8_STAGE(PG8_SA(0, 1), a2 + hstepA, voffA);
            PG8_WAIT_L(8); PG8_BAR; PG8_WAIT_L(0); PG8_MMA(0, 0, At, B0); PG8_BAR; PG8_SCHED;
            PG8_LDB(B1, 1, 1); PG8_STAGE(PG8_SB(1, 0), b3, voffB);
            PG8_BAR; PG8_WAIT_L(0); PG8_MMA(0, 1, At, B1); PG8_BAR;
            PG8_LDA(At, 1, 1); PG8_STAGE(PG8_SA(1, 0), a3, voffA);
            PG8_BAR; PG8_WAIT_L(0); PG8_MMA(1, 0, At, B0); PG8_BAR; PG8_SCHED;
            PG8_STAGE(PG8_SB(1, 1), b3 + hstepB, voffB);
            PG8_WAIT_V(6); PG8_BAR; PG8_MMA(1, 1, At, B1); PG8_BAR;
            }
        }
        if constexpr (ALIGN_EPI) { if (wr == 0) PG8_BAR; }
        if constexpr (!Epi::AFTER_DRAIN) { E(acc, cur, wr, wc, fr, fq); S.done(cur); }
        if (!has_next) break;
#pragma unroll
        for (int a = 0; a < 2; ++a)
#pragma unroll
            for (int b = 0; b < 2; ++b)
#pragma unroll
                for (int m = 0; m < 4; ++m)
#pragma unroll
                    for (int n = 0; n < 2; ++n) acc[a][b][m][n] = (f32x4){0.f, 0.f, 0.f, 0.f};
        cur = nxt; cA = nA; cB = nB; ++ui;
        if constexpr (ALIGN_EPI) { if (wr == 1) PG8_BAR; }
    }
    PG8_WAIT_V(0);
    if constexpr (!ALIGN_EPI) { if (wr == 0) PG8_BAR; }
    PG8_BAR;
    if constexpr (Epi::AFTER_DRAIN) { E.fused(acc, cur, wr, wc, fr, fq, lds, wid, lane); S.done(cur); }
#undef PG8_SA
#undef PG8_SB
#undef PG8_STAGE
#undef PG8_LDA
#undef PG8_LDB
#undef PG8_MMA
#undef PG8_WAIT_V
#undef PG8_WAIT_L
#undef PG8_BAR
#undef PG8_SCHED
}
}
#define GAS __attribute__((address_space(1)))
#define LAS __attribute__((address_space(3)))
typedef unsigned short bf16;
typedef unsigned v4u __attribute__((ext_vector_type(4)));
typedef float f32x4 __attribute__((ext_vector_type(4)));
typedef short bf16x8 __attribute__((ext_vector_type(8)));
typedef unsigned v2u __attribute__((ext_vector_type(2)));
typedef GAS unsigned gu32;
typedef GAS unsigned long long gu64;
#define RLX_AGENT __ATOMIC_RELAXED, __HIP_MEMORY_SCOPE_AGENT
#define LDS_WAIT() asm volatile("s_waitcnt lgkmcnt(0)" ::: "memory")
#define VM_WAIT() asm volatile("s_waitcnt vmcnt(0)" ::: "memory")
__device__ __forceinline__ unsigned long long rt() { return __builtin_amdgcn_s_memrealtime(); }
__device__ __forceinline__ unsigned f2bf(float f) { unsigned u = __builtin_bit_cast(unsigned, f); return (u + 0x7fffu + ((u >> 16) & 1u)) >> 16; }
__device__ __forceinline__ unsigned pk2(float lo, float hi) { return f2bf(lo) | (f2bf(hi) << 16); }
#define XB_TMO      128
#define XB_XCNT(j)  (256  + 64 * (j))
#define XB_XSUB(j)  (1280 + 64 * (j))
#define XB_XGEN(j)  (2304 + 64 * (j))
#define XB_TOP      3328
#define XB_TOPGEN   3392
#define XCD_BAR_WORDS 3456
#define XB_SPIN_CAP (1u << 18)

__device__ __forceinline__ unsigned xb_ld(unsigned* p)              { return __hip_atomic_load(p, __ATOMIC_RELAXED, __HIP_MEMORY_SCOPE_AGENT); }
__device__ __forceinline__ unsigned xb_add(unsigned* p, unsigned v) { return __hip_atomic_fetch_add(p, v, __ATOMIC_RELAXED, __HIP_MEMORY_SCOPE_AGENT); }
__device__ __forceinline__ unsigned xb_xcc_id() { return (unsigned)__builtin_amdgcn_s_getreg((3 << 11) | 20) & 0xFu; }
#define XB_SPIN(cond, bar) do { unsigned _sp = 0; while (cond) { __builtin_amdgcn_s_sleep(1); \
    if ((++_sp & 255u) == 0u) { if (xb_ld(&(bar)[XB_TMO])) break; if (_sp > XB_SPIN_CAP) { atomicAdd(&(bar)[XB_TMO], 1u); break; } } } } while (0)

struct XcdBarrier {
    unsigned* bar; unsigned x;
    volatile LAS unsigned* st;
};

__device__ __forceinline__ XcdBarrier xcd_barrier_post(unsigned* bar, volatile LAS unsigned* st, const bool t0) {
    XcdBarrier b; b.bar = bar; b.x = xb_xcc_id(); b.st = st;
    if (t0) (void)xb_add(&bar[XB_XCNT(b.x)], 1u);
    return b;
}
__device__ __forceinline__ void xcd_barrier_complete(unsigned* bar, unsigned x, unsigned& nloc, unsigned& nx) {
    const unsigned G = gridDim.x * gridDim.y * gridDim.z;
    unsigned sum, cnt, mine, sp = 0u;
    for (;;) {
        sum = 0u; cnt = 0u; mine = 0u;
#pragma unroll
        for (unsigned j = 0; j < 16; ++j) { const unsigned c = xb_ld(&bar[XB_XCNT(j)]); sum += c; cnt += (c > 0u) ? 1u : 0u; mine = (j == x) ? c : mine; }
        if (sum == G) break;
        __builtin_amdgcn_s_sleep(1);
        if ((++sp & 255u) == 0u) { if (xb_ld(&bar[XB_TMO])) break; if (sp > XB_SPIN_CAP) { atomicAdd(&bar[XB_TMO], 1u); break; } }
    }
    nloc = mine > 0u ? mine : 1u; nx = cnt > 0u ? cnt : 1u;
}

template <bool FIRST> __device__ __forceinline__ void xcd_barrier(const XcdBarrier& b, const bool t0) {
    asm volatile("s_waitcnt vmcnt(0)" ::: "memory");
    __syncthreads();
    if (t0) {
        unsigned* bar = b.bar; unsigned bx = b.x; asm volatile("" : "+s"(bar), "+s"(bx));
        __builtin_amdgcn_s_waitcnt(0);
        unsigned nloc = b.st[0], nx = b.st[1];
        if constexpr (FIRST) { if (nloc == 0u) { xcd_barrier_complete(bar, bx, nloc, nx); b.st[0] = nloc; b.st[1] = nx; } }
        const unsigned old = xb_add(&bar[XB_XSUB(bx)], 1u);
        const unsigned gen = old / nloc;
        if (old + 1u == (gen + 1u) * nloc) {
            __builtin_amdgcn_fence(__ATOMIC_RELEASE, "agent");
            asm volatile("s_waitcnt vmcnt(0)" ::: "memory");
            const unsigned og = xb_add(&bar[XB_TOP], 1u);
            const unsigned tg = og / nx;
            if (og + 1u == (tg + 1u) * nx) xb_add(&bar[XB_TOPGEN], 1u);
            else XB_SPIN(xb_ld(&bar[XB_TOPGEN]) == tg, bar);
            __builtin_amdgcn_fence(__ATOMIC_ACQUIRE, "agent");
            xb_add(&bar[XB_XGEN(bx)], 1u);
            asm volatile("s_waitcnt vmcnt(0)" ::: "memory");
        } else {
            XB_SPIN(xb_ld(&bar[XB_XGEN(bx)]) == gen, bar);
            __builtin_amdgcn_fence(__ATOMIC_ACQUIRE, "agent");
            asm volatile("s_waitcnt vmcnt(0)" ::: "memory");
        }
    }
    __syncthreads();
}

constexpr size_t MiB = 1u << 20;
constexpr size_t WS_CTL = 0, CTL_ZERO_BYTES = 1 * MiB;
constexpr size_t WS_MOD = 1 * MiB;
constexpr size_t WS_COS = 2 * MiB, WS_SIN = 6 * MiB;
constexpr size_t WS_RSQ = 10 * MiB, WS_RSKV = 10 * MiB + 512 * 1024;
constexpr size_t WS_KROPE = 11 * MiB;
constexpr size_t WS_GPREP = 15 * MiB;
constexpr size_t WS_W = 24 * MiB, W_LAYER = 92 * MiB;
constexpr size_t WO_IN = 0, WO_UQ = 17 * MiB, WO_UKV = 17 * MiB + 768 * 1024, WO_OUT = 18 * MiB, WO_GU = 26 * MiB, WO_DN = 70 * MiB;
constexpr size_t WS_HBUF = 208 * MiB;
constexpr size_t WS_YBUF = 336 * MiB;
constexpr size_t WS_HF = WS_HBUF;
constexpr size_t WS_YCAT = 464 * MiB;
constexpr size_t WS_PROJ = 592 * MiB;
constexpr size_t WS_QMLA = 864 * MiB;
constexpr size_t WS_KVMLA = 912 * MiB;
constexpr size_t WS_ABUF = WS_PROJ;
constexpr size_t WS_END = 976 * MiB;
static_assert(WS_W + 2 * W_LAYER <= WS_HBUF && WS_HF + (size_t)2 * M * 768 * 4 <= WS_YCAT && WS_ABUF + (size_t)M * DFF * 2 <= WS_END, "d_ws map");
static_assert(WO_IN + (size_t)NINP * DM * 2 <= WO_UQ && WO_UQ + (size_t)NQB * QLP * 2 <= WO_UKV && WO_UKV + (size_t)NKVB * KVL * 2 <= WO_OUT && WO_OUT + (size_t)DM * DM * 2 <= WO_GU && WO_GU + (size_t)2 * DFF * DM * 2 <= WO_DN && WO_DN + (size_t)DM * DFF * 2 <= W_LAYER, "weight map");
constexpr int CW_BAR = 4096;
constexpr int CW_Q = 16384;

constexpr int RING_OFF = 0, RING_BYTES = 131072;
constexpr int LDSCTL_OFF = RING_BYTES, MISC_OFF = LDSCTL_OFF + 320;
constexpr int LDS_BYTES = 147456;
constexpr int NWAVES = 8, NTHR = 512;

__device__ __forceinline__ float wave_sum(float v) {
#pragma unroll
    for (int o = 1; o < 64; o <<= 1) v += __shfl_xor(v, o);
    return v;
}
__device__ __forceinline__ float bf2f(unsigned short b) { return __builtin_bit_cast(float, (unsigned)b << 16); }
__device__ __forceinline__ float bflo(unsigned w) { return __builtin_bit_cast(float, w << 16); }
__device__ __forceinline__ float bfhi(unsigned w) { return __builtin_bit_cast(float, w & 0xffff0000u); }

__constant__ double INVF[32] = {1.0, 0.7498942093324559, 0.5623413251903491, 0.4216965034285822, 0.31622776601683794, 0.23713737056616552, 0.1778279410038923, 0.1333521432163324, 0.1, 0.07498942093324558, 0.05623413251903491, 0.042169650342858224, 0.03162277660168379, 0.023713737056616554, 0.01778279410038923, 0.01333521432163324, 0.01, 0.007498942093324558, 0.005623413251903491, 0.004216965034285823, 0.0031622776601683794, 0.0023713737056616554, 0.0017782794100389228, 0.001333521432163324, 0.001, 0.0007498942093324559, 0.0005623413251903491, 0.00042169650342858224, 0.00031622776601683794, 0.00023713737056616554, 0.00017782794100389227, 0.0001333521432163324};
__constant__ float ALIBI[12] = {0.5f, 0.25f, 0.125f, 0.0625f, 0.03125f, 0.015625f, 0.0078125f, 0.00390625f, 0.7071067690849304f, 0.3535533845424652f, 0.1767766922712326f, 0.0883883461356163f};

__device__ __forceinline__ int lane_id() { int l = (int)__builtin_amdgcn_mbcnt_hi(~0u, __builtin_amdgcn_mbcnt_lo(~0u, 0u)); asm volatile("" : "+v"(l)); return l; }
struct Args { const void* in[21]; float* out; unsigned char* ws; int ph_lo, ph_hi; };
typedef const __attribute__((address_space(4))) Args* KArgs;
__device__ __forceinline__ KArgs kargs() { KArgs p = (KArgs)__builtin_amdgcn_kernarg_segment_ptr(); asm volatile("" : "+s"(p)); return p; }

enum { WK_IN = 0, WK_UQ, WK_UKV, WK_OUT, WK_GATE, WK_UP, WK_DN };
__device__ __forceinline__ int wk_row(int kind, int n) {
    if (kind == WK_UQ) { const int hd = n / 192, hc = n % 192; if (hc < 128) return n; const int i = hc - 128; return hd * 192 + 128 + (i < 32 ? 2 * i : 2 * (i - 32) + 1); }
    if (kind == WK_GATE) return (n >> 7) * 256 + (n & 127);
    if (kind == WK_UP) return (n >> 7) * 256 + 128 + (n & 127);
    return n;
}
__device__ __forceinline__ float wk_colscale(int kind, int n) {
    if (kind == WK_IN) { if (n < C_AK) return QSCALE_A; if (n >= C_CQ && n < C_CK) return QSCALE_C; }
    return 1.0f;
}
__device__ __forceinline__ void transpose_item(const float* W, int K, int N, bf16* WT, int ldt, int kind, const float* rowg, LAS float* scr, int item, int lane) {
    const int nblk = (N + 31) / 32, kb = item / nblk, nb = item % nblk, k0 = 64 * kb, n0 = 32 * nb;
    { const int n = n0 + (lane & 31); const float csn = wk_colscale(kind, n);
#pragma unroll 8
      for (int i = 0; i < 32; ++i) { const int kk = 2 * i + (lane >> 5); float v = 0.f; if (n < N) v = W[(size_t)(k0 + kk) * N + n] * csn; if (rowg) v *= rowg[k0 + kk]; scr[kk * 33 + (lane & 31)] = v; } }
    LDS_WAIT(); asm volatile("" ::: "memory");
    const int c = lane & 7;
#pragma unroll
    for (int j = 0; j < 4; ++j) { const int nl = (lane >> 3) + 8 * j; const LAS float* s = scr + (8 * c) * 33 + nl; const int drow = wk_row(kind, n0 + nl);
        v4u o; o.x = pk2(s[0 * 33], s[1 * 33]); o.y = pk2(s[2 * 33], s[3 * 33]); o.z = pk2(s[4 * 33], s[5 * 33]); o.w = pk2(s[6 * 33], s[7 * 33]);
        *(GAS v4u*)(WT + (size_t)drow * ldt + k0 + 8 * c) = o; }
    LDS_WAIT(); asm volatile("" ::: "memory");
}
__device__ __forceinline__ void sincos_rev(double r, float& sn, float& cs) {
    const double k = __builtin_rint(4.0 * r); const double f = r - 0.25 * k; const double y = 6.283185307179586476925 * f; const double y2 = y * y;
    double s = y * (1.0 + y2 * (-1.0 / 6 + y2 * (1.0 / 120 + y2 * (-1.0 / 5040 + y2 * (1.0 / 362880 + y2 * (-1.0 / 39916800 + y2 * (1.0 / 6227020800.0)))))));
    double c = 1.0 + y2 * (-0.5 + y2 * (1.0 / 24 + y2 * (-1.0 / 720 + y2 * (1.0 / 40320 + y2 * (-1.0 / 3628800 + y2 * (1.0 / 479001600.0 + y2 * (-1.0 / 87178291200.0)))))));
    const int q = ((int)k) & 3; double ss, cc;
    if (q == 0) { ss = s; cc = c; } else if (q == 1) { ss = c; cc = -s; } else if (q == 2) { ss = -s; cc = -c; } else { ss = -c; cc = s; }
    sn = (float)ss; cs = (float)cc;
}

__device__ __forceinline__ void row_norm(const float* xin, const bf16* br, const float* gate, const float* gpost, float* xout, bf16* hout, const float* gpre, const float* scale, const float* shift, int lane) {
    f32x4 v[8];
#pragma unroll
    for (int j = 0; j < 8; ++j) v[j] = *(const GAS f32x4*)(xin + 4 * (64 * j + lane));
    if (br) {
        f32x4 y[8]; float ss = 0.f;
#pragma unroll
        for (int j = 0; j < 8; ++j) { const v2u w = *(const GAS v2u*)(br + 4 * (64 * j + lane)); y[j] = (f32x4){bflo(w.x), bfhi(w.x), bflo(w.y), bfhi(w.y)}; ss += (y[j][0] * y[j][0] + y[j][1] * y[j][1]) + (y[j][2] * y[j][2] + y[j][3] * y[j][3]); }
        const float rstd = 1.0f / sqrtf(wave_sum(ss) * (1.0f / DM) + EPS);
#pragma unroll
        for (int j = 0; j < 8; ++j) { const f32x4 g = *(const GAS f32x4*)(gate + 4 * (64 * j + lane)), p = *(const GAS f32x4*)(gpost + 4 * (64 * j + lane)); v[j] = v[j] + g * (y[j] * rstd * p); }
    }
    if (xout) {
#pragma unroll
        for (int j = 0; j < 8; ++j) *(GAS f32x4*)(xout + 4 * (64 * j + lane)) = v[j];
    }
    if (hout) {
        float ss = 0.f;
#pragma unroll
        for (int j = 0; j < 8; ++j) ss += (v[j][0] * v[j][0] + v[j][1] * v[j][1]) + (v[j][2] * v[j][2] + v[j][3] * v[j][3]);
        const float rstd = 1.0f / sqrtf(wave_sum(ss) * (1.0f / DM) + EPS);
#pragma unroll
        for (int j = 0; j < 8; ++j) { const int c = 4 * (64 * j + lane); const f32x4 g = *(const GAS f32x4*)(gpre + c), sc = *(const GAS f32x4*)(scale + c), sh = *(const GAS f32x4*)(shift + c);
            const f32x4 h = v[j] * rstd * g * (sc + 1.0f) + sh; v2u w; w.x = pk2(h[0], h[1]); w.y = pk2(h[2], h[3]); *(GAS v2u*)(hout + c) = w; }
    }
}

struct WDesc { const float* W; int K, N; bf16* WT; int ldt, kind; const float* rowg; int nitems; };
__device__ __forceinline__ void p0_prologue(KArgs a, LAS unsigned char* lds, int wave, int lane, int tid) {
    const int G = gridDim.x, gw = blockIdx.x * NWAVES + wave, NGW = G * NWAVES;
    LAS float* scr = (LAS float*)(lds + RING_OFF + wave * 16384);
    for (int l = 0; l < DEPTH; ++l) {
        unsigned char* wb = a->ws + WS_W + (size_t)l * W_LAYER;
        WDesc d[7];
        d[0] = WDesc{(const float*)a->in[9] + (size_t)l * DM * NIN, DM, NIN, (bf16*)(wb + WO_IN), DM, WK_IN, nullptr, 0};
        d[1] = WDesc{(const float*)a->in[12] + (size_t)l * QL * NQB, QL, NQB, (bf16*)(wb + WO_UQ), QLP, WK_UQ, (const float*)a->in[11] + l * QL, 0};
        d[2] = WDesc{(const float*)a->in[14] + (size_t)l * KVL * NKVB, KVL, NKVB, (bf16*)(wb + WO_UKV), KVL, WK_UKV, (const float*)a->in[13] + l * KVL, 0};
        d[3] = WDesc{(const float*)a->in[17] + (size_t)l * DM * DM, DM, DM, (bf16*)(wb + WO_OUT), DM, WK_OUT, nullptr, 0};
        d[4] = WDesc{(const float*)a->in[18] + (size_t)l * DM * DFF, DM, DFF, (bf16*)(wb + WO_GU), DM, WK_GATE, nullptr, 0};
        d[5] = WDesc{(const float*)a->in[19] + (size_t)l * DM * DFF, DM, DFF, (bf16*)(wb + WO_GU), DM, WK_UP, nullptr, 0};
        d[6] = WDesc{(const float*)a->in[20] + (size_t)l * DFF * DM, DFF, DM, (bf16*)(wb + WO_DN), DFF, WK_DN, nullptr, 0};
        int tot = 0;
#pragma unroll
        for (int i = 0; i < 7; ++i) { d[i].nitems = (d[i].K / 64) * ((d[i].N + 31) / 32); tot += d[i].nitems; }
        for (int it = gw; it < tot; it += NGW) {
            int r = it;
#pragma unroll
            for (int i = 0; i < 7; ++i) { if (r >= 0 && r < d[i].nitems) transpose_item(d[i].W, d[i].K, d[i].N, d[i].WT, d[i].ldt, d[i].kind, d[i].rowg, scr, r, lane); r -= d[i].nitems; }
        }
        { bf16* wt = (bf16*)(wb + WO_IN); const int n16 = (NINP - 4256) * DM / 8;
          for (int i = blockIdx.x * NTHR + tid; i < n16; i += G * NTHR) *(GAS v4u*)(wt + (size_t)4256 * DM + (size_t)i * 8) = (v4u){0u, 0u, 0u, 0u};
          bf16* wq = (bf16*)(wb + WO_UQ); const int q16 = NQB * (QLP - QL) / 8;
          for (int i = blockIdx.x * NTHR + tid; i < q16; i += G * NTHR) { const int rr = i / ((QLP - QL) / 8), cc = i % ((QLP - QL) / 8); *(GAS v4u*)(wq + (size_t)rr * QLP + QL + cc * 8) = (v4u){0u, 0u, 0u, 0u}; } }
    }
    { const int* pos = (const int*)a->in[2]; float* cs = (float*)(a->ws + WS_COS); float* sn = (float*)(a->ws + WS_SIN);
      for (int i = blockIdx.x * NTHR + tid; i < M * 32; i += G * NTHR) { const int m = i >> 5, k = i & 31; const double ang = (double)pos[m] * INVF[k] * 0.15915494309189533577; const double r = ang - __builtin_floor(ang);
          float s, c; sincos_rev(r, s, c); cs[i] = c; sn[i] = s; } }
    __syncthreads();
    { LAS float* sc = (LAS float*)(lds + RING_OFF);
      LAS float* red = (LAS float*)(lds + RING_OFF + 65536);
      const float* cin = (const float*)a->in[1];
      for (int i = tid; i < BATCH * DM; i += NTHR) { const float x = cin[i]; sc[i] = x / (1.0f + __expf(-x)); }
      __syncthreads();
      const float* mw = (const float*)a->in[3]; const float* mb = (const float*)a->in[4]; float* mod = (float*)(a->ws + WS_MOD);
      for (int cg = blockIdx.x; cg < 256; cg += G) {
          const int l = cg / 128, n0 = (cg % 128) * 96;
          if (tid < 384) { const int cc = tid % 96, ks = tid / 96; const float* wp = mw + ((size_t)l * DM + ks * 512) * NMOD + n0 + cc; float acc[8];
#pragma unroll
              for (int b = 0; b < 8; ++b) acc[b] = 0.f;
#pragma unroll 8
              for (int k = 0; k < 512; ++k) { const float w = wp[(size_t)k * NMOD];
#pragma unroll
                  for (int b = 0; b < 8; ++b) acc[b] += sc[b * DM + ks * 512 + k] * w; }
#pragma unroll
              for (int b = 0; b < 8; ++b) red[(ks * 8 + b) * 96 + cc] = acc[b]; }
          __syncthreads();
          for (int i = tid; i < 768; i += NTHR) { const int b = i / 96, cc = i % 96; const float s = (red[(0 * 8 + b) * 96 + cc] + red[(1 * 8 + b) * 96 + cc]) + (red[(2 * 8 + b) * 96 + cc] + red[(3 * 8 + b) * 96 + cc]);
              mod[((size_t)l * BATCH + b) * NMOD + n0 + cc] = s + mb[(size_t)l * NMOD + n0 + cc]; }
          __syncthreads();
      }
    }
}

__device__ __forceinline__ void prep_rows(KArgs a, int wave, int lane) {
    const bf16* proj = (const bf16*)(a->ws + WS_PROJ); float* rsq = (float*)(a->ws + WS_RSQ); float* rskv = (float*)(a->ws + WS_RSKV); bf16* kr = (bf16*)(a->ws + WS_KROPE);
    const float* cs = (const float*)(a->ws + WS_COS); const float* sn = (const float*)(a->ws + WS_SIN);
    const int gw = blockIdx.x * NWAVES + wave, NGW = gridDim.x * NWAVES;
    for (int m = gw; m < M; m += NGW) {
        const bf16* p = proj + (size_t)m * NINP;
        float s1 = 0.f, s2 = 0.f;
        if (lane < 56) { const v4u w = *(const GAS v4u*)(p + C_BCQ + lane * 8);
#pragma unroll
            for (int j = 0; j < 4; ++j) { const float x = bflo(w[j]), y = bfhi(w[j]); s1 += x * x + y * y; } }
        if (lane < 16) { const v4u w = *(const GAS v4u*)(p + C_BCKV + lane * 8);
#pragma unroll
            for (int j = 0; j < 4; ++j) { const float x = bflo(w[j]), y = bfhi(w[j]); s2 += x * x + y * y; } }
        s1 = wave_sum(s1); s2 = wave_sum(s2);
        if (lane == 0) { rsq[m] = 1.0f / sqrtf(s1 * (1.0f / QL) + EPS); rskv[m] = 1.0f / sqrtf(s2 * (1.0f / KVL) + EPS); }
        if (lane < 32) { const float x1 = bf2f(p[C_BKR + lane]), x2 = bf2f(p[C_BKR + 32 + lane]); const float c = cs[(size_t)m * 32 + lane], s = sn[(size_t)m * 32 + lane];
            *(GAS unsigned*)(kr + (size_t)m * 64 + 2 * lane) = pk2(x1 * c - x2 * s, x1 * s + x2 * c); }
    }
}

__device__ __forceinline__ void ld8(const bf16* p, float* o) { const v4u w = *(const GAS v4u*)p;
#pragma unroll
    for (int j = 0; j < 4; ++j) { o[2 * j] = bflo(w[j]); o[2 * j + 1] = bfhi(w[j]); } }

__device__ __forceinline__ void naive_window(KArgs a, int l, int tid) {
    const bf16* proj = (const bf16*)(a->ws + WS_PROJ); bf16* ycat = (bf16*)(a->ws + WS_YCAT); const float* sink = (const float*)a->in[10] + l * 12;
    const int gt = blockIdx.x * NTHR + tid, NT = gridDim.x * NTHR;
    for (int it = gt; it < M * 12; it += NT) {
        const int m = it / 12, hq = it % 12, b = m / SEQ, t = m % SEQ, kvh = hq / 3;
        float q[64], acc[64];
#pragma unroll
        for (int j = 0; j < 8; ++j) ld8(proj + (size_t)m * NINP + C_AQ + hq * 64 + 8 * j, q + 8 * j);
#pragma unroll
        for (int d = 0; d < 64; ++d) acc[d] = 0.f;
        float mr = sink[hq] * LOG2E, lr = 1.0f; const float slope = ALIBI[hq] * LOG2E;
        const int s0 = t - 128 < 0 ? 0 : t - 128, s1 = t + 128 > SEQ - 1 ? SEQ - 1 : t + 128;
        for (int s = s0; s <= s1; ++s) {
            const bf16* kp = proj + (size_t)(b * SEQ + s) * NINP + C_AK + kvh * 64; const bf16* vp = proj + (size_t)(b * SEQ + s) * NINP + C_AV + kvh * 64;
            float dot = 0.f;
#pragma unroll
            for (int j = 0; j < 8; ++j) { float k8[8]; ld8(kp + 8 * j, k8);
#pragma unroll
                for (int e = 0; e < 8; ++e) dot += q[8 * j + e] * k8[e]; }
            const int dist = t > s ? t - s : s - t; const float sc = dot - slope * (float)dist;
            const float mn = fmaxf(mr, sc), corr = __builtin_amdgcn_exp2f(mr - mn), p = __builtin_amdgcn_exp2f(sc - mn); lr = lr * corr + p; mr = mn;
#pragma unroll
            for (int j = 0; j < 8; ++j) { float v8[8]; ld8(vp + 8 * j, v8);
#pragma unroll
                for (int e = 0; e < 8; ++e) acc[8 * j + e] = acc[8 * j + e] * corr + p * v8[e]; }
        }
        const float inv = 1.0f / lr; bf16* op = ycat + (size_t)m * DM + hq * 64;
#pragma unroll
        for (int j = 0; j < 8; ++j) { v4u w; w.x = pk2(acc[8 * j] * inv, acc[8 * j + 1] * inv); w.y = pk2(acc[8 * j + 2] * inv, acc[8 * j + 3] * inv); w.z = pk2(acc[8 * j + 4] * inv, acc[8 * j + 5] * inv); w.w = pk2(acc[8 * j + 6] * inv, acc[8 * j + 7] * inv); *(GAS v4u*)(op + 8 * j) = w; }
    }
}
__device__ __forceinline__ void naive_mla(KArgs a, int tid) {
    const bf16* qm = (const bf16*)(a->ws + WS_QMLA); const bf16* kv = (const bf16*)(a->ws + WS_KVMLA); const bf16* kr = (const bf16*)(a->ws + WS_KROPE); bf16* ycat = (bf16*)(a->ws + WS_YCAT);
    const int gt = blockIdx.x * NTHR + tid, NT = gridDim.x * NTHR, g = gt & 3;
    for (int it = gt >> 2; it < M * 4; it += NT >> 2) {
        const int m = it >> 2, h = it & 3, b = m / SEQ;
        float q[48], acc[32];
#pragma unroll
        for (int j = 0; j < 4; ++j) ld8(qm + (size_t)m * NQB + h * 192 + 32 * g + 8 * j, q + 8 * j);
#pragma unroll
        for (int j = 0; j < 2; ++j) ld8(qm + (size_t)m * NQB + h * 192 + 128 + 16 * g + 8 * j, q + 32 + 8 * j);
#pragma unroll
        for (int d = 0; d < 32; ++d) acc[d] = 0.f;
        float mr = -INFINITY, lr = 0.f;
        for (int s = 0; s < SEQ; ++s) {
            const size_t row = (size_t)b * SEQ + s; const bf16* kp = kv + row * NKVB + h * 256 + 32 * g; const bf16* rp = kr + row * 64 + 16 * g; const bf16* vp = kv + row * NKVB + h * 256 + 128 + 32 * g;
            float dot = 0.f;
#pragma unroll
            for (int j = 0; j < 4; ++j) { float k8[8]; ld8(kp + 8 * j, k8);
#pragma unroll
                for (int e = 0; e < 8; ++e) dot += q[8 * j + e] * k8[e]; }
#pragma unroll
            for (int j = 0; j < 2; ++j) { float k8[8]; ld8(rp + 8 * j, k8);
#pragma unroll
                for (int e = 0; e < 8; ++e) dot += q[32 + 8 * j + e] * k8[e]; }
            dot += __shfl_xor(dot, 1); dot += __shfl_xor(dot, 2);
            const float mn = fmaxf(mr, dot), corr = __builtin_amdgcn_exp2f(mr - mn), p = __builtin_amdgcn_exp2f(dot - mn); lr = lr * corr + p; mr = mn;
#pragma unroll
            for (int j = 0; j < 4; ++j) { float v8[8]; ld8(vp + 8 * j, v8);
#pragma unroll
                for (int e = 0; e < 8; ++e) acc[8 * j + e] = acc[8 * j + e] * corr + p * v8[e]; }
        }
        const float inv = 1.0f / lr; bf16* op = ycat + (size_t)m * DM + 768 + h * 128 + 32 * g;
#pragma unroll
        for (int j = 0; j < 4; ++j) { v4u w; w.x = pk2(acc[8 * j] * inv, acc[8 * j + 1] * inv); w.y = pk2(acc[8 * j + 2] * inv, acc[8 * j + 3] * inv); w.z = pk2(acc[8 * j + 4] * inv, acc[8 * j + 5] * inv); w.w = pk2(acc[8 * j + 6] * inv, acc[8 * j + 7] * inv); *(GAS v4u*)(op + 8 * j) = w; }
    }
}
__device__ __forceinline__ void naive_mlstm(KArgs a, int l, LAS unsigned char* lds, int tid) {
    const bf16* proj = (const bf16*)(a->ws + WS_PROJ); float* hf = (float*)(a->ws + WS_HF); const float* gb = (const float*)a->in[15] + l * 16;
    LAS float* den_s = (LAS float*)(lds + RING_OFF); LAS float* mt_s = den_s + SEQ;
    for (int job = blockIdx.x; job < 64; job += gridDim.x) {
        const int dir = job & 1, bh = job >> 1, b = bh >> 2, h = bh & 3; const int e = tid;
        float* hd = hf + (size_t)dir * M * 768;
        if (e <= 192) {
            float C[96];
#pragma unroll
            for (int d = 0; d < 96; ++d) C[d] = 0.f;
            float mrun = -INFINITY;
            const float bi = gb[(dir ? 1 : 0) * 4 + h], bfg = gb[(dir ? 3 : 2) * 4 + h];
            for (int tt = 0; tt < SEQ; ++tt) {
                const int t = dir ? SEQ - 1 - tt : tt; const bf16* p = proj + (size_t)(b * SEQ + t) * NINP;
                const float li = bf2f(p[C_CG + (dir ? 1 : 0) * 4 + h]) + bi, fp = bf2f(p[C_CG + (dir ? 3 : 2) * 4 + h]) + bfg;
                const float lf = fminf(fp, 0.f) - log1pf(__expf(-fabsf(fp)));
                const float mn = fmaxf(lf + mrun, li), fa = __expf(lf + mrun - mn), fb = __expf(li - mn); mrun = mn;
                const float v = (e < 192) ? bf2f(p[C_CV + h * 192 + e]) : 1.0f; const float bv = fb * v;
                float num = 0.f;
#pragma unroll
                for (int j = 0; j < 12; ++j) { float q8[8], k8[8]; ld8(p + C_CQ + h * 96 + 8 * j, q8); ld8(p + C_CK + h * 96 + 8 * j, k8);
#pragma unroll
                    for (int d = 0; d < 8; ++d) { C[8 * j + d] = fa * C[8 * j + d] + bv * k8[d]; num += q8[d] * C[8 * j + d]; } }
                if (e < 192) hd[(size_t)(b * SEQ + t) * 768 + h * 192 + e] = num; else { den_s[t] = num; mt_s[t] = mn; }
            }
        }
        __syncthreads();
        if (e < 192) { for (int t = 0; t < SEQ; ++t) { float* q = hd + (size_t)(b * SEQ + t) * 768 + h * 192 + e; *q = *q / fmaxf(fabsf(den_s[t]), __expf(-mt_s[t])); } }
        __syncthreads();
    }
}
__device__ __forceinline__ void mlstm_combine(KArgs a, int l, int wave, int lane) {
    const bf16* proj = (const bf16*)(a->ws + WS_PROJ); const float* hf = (const float*)(a->ws + WS_HF); const float* hb = hf + (size_t)M * 768; bf16* ycat = (bf16*)(a->ws + WS_YCAT);
    const float* hg = (const float*)a->in[16] + l * 768;
    const int gw = blockIdx.x * NWAVES + wave, NGW = gridDim.x * NWAVES;
    for (int m = gw; m < M; m += NGW) {
#pragma unroll
        for (int h = 0; h < 4; ++h) { float x[3]; float ss = 0.f;
#pragma unroll
            for (int j = 0; j < 3; ++j) { const int c = h * 192 + 64 * j + lane; x[j] = hf[(size_t)m * 768 + c] + hb[(size_t)m * 768 + c]; ss += x[j] * x[j]; }
            const float rstd = 1.0f / sqrtf(wave_sum(ss) * (1.0f / 192) + EPS);
#pragma unroll
            for (int j = 0; j < 3; ++j) { const int c = h * 192 + 64 * j + lane; const float o = bf2f(proj[(size_t)m * NINP + C_CO + c]); const float sg = 1.0f / (1.0f + __expf(-o));
                ycat[(size_t)m * DM + 1280 + c] = (bf16)f2bf(sg * x[j] * rstd * hg[c]); } }
    }
}

constexpr int PH_PER_LAYER = 11, N_PHASES = 1 + DEPTH * PH_PER_LAYER;
#ifndef MK_N_LAUNCHES
#define MK_N_LAUNCHES 1
#endif
#define lane (lane_id())
#define tid (wave * 64 + lane)
#define gw ((int)blockIdx.x * NWAVES + wave)
#define wsp() (kargs()->ws)
#define x_in ((const float*)kargs()->in[0])
#define xres (kargs()->out)
#define HB ((bf16*)(wsp() + WS_HBUF))
#define YB ((bf16*)(wsp() + WS_YBUF))
#define YC ((bf16*)(wsp() + WS_YCAT))
#define PJ ((bf16*)(wsp() + WS_PROJ))
#define QM ((bf16*)(wsp() + WS_QMLA))
#define KVM ((bf16*)(wsp() + WS_KVMLA))
#define AB ((bf16*)(wsp() + WS_ABUF))
#define modp ((const float*)(wsp() + WS_MOD))
#define IN(k) (lo <= (k) && (k) < hi)
#define SEAM(k) do { if (IN(k) && IN((k) + 1)) xcd_barrier<false>(bar, tid == 0); } while (0)
#define SEAM0(k) do { if (IN(k) && IN((k) + 1)) xcd_barrier<true>(bar, tid == 0); } while (0)

template <int l> __device__ __forceinline__ void layer_phases(LAS unsigned char* lds, const XcdBarrier& bar, const int wave, const int lo, const int hi) {
    const int G = gridDim.x, NGW = G * NWAVES;
    constexpr int pb = 1 + l * PH_PER_LAYER;
#define wb (wsp() + WS_W + (size_t)l * W_LAYER)
#define modl (modp + (size_t)l * BATCH * NMOD)
    if (l == 0 && IN(pb + 0)) {
        const float* g = (const float*)kargs()->in[5] + l * DM; const int ln = lane;
        for (int m = gw; m < M; m += NGW) { const int b = m / SEQ; const float* mb = modl + (size_t)b * NMOD;
            row_norm(x_in + (size_t)m * DM, nullptr, nullptr, nullptr, nullptr, HB + (size_t)m * DM, g, mb + 1 * DM, mb + 0 * DM, ln); }
    }
    SEAM(pb + 0);
    if (IN(pb + 1)) {
        pg8::Gemm g{HB, (const bf16*)(wb + WO_IN), M, NINP, DM, DM}; pg8::StaticOrder S; S.init(M, NINP, G, (int)blockIdx.x);
        pg8::EpiBf16 E{PJ, NINP};
        pg8::gemm_phase<pg8::EpiBf16, pg8::StaticOrder, true, true>(lds + RING_OFF, g, S, E, wave);
    }
    SEAM(pb + 1);
    if (IN(pb + 2)) prep_rows(kargs(), wave, lane);
    SEAM(pb + 2);
    if (IN(pb + 3)) {
        { pg8::Gemm g{PJ + C_BCQ, (const bf16*)(wb + WO_UQ), M, NQB, QLP, NINP}; pg8::StaticOrder S; S.init(M, NQB, G, (int)blockIdx.x);
          pg8::EpiQRope E{QM, NQB, (const float*)(wsp() + WS_RSQ), QSCALE_B, (const float*)(wsp() + WS_COS), (const float*)(wsp() + WS_SIN)};
          pg8::gemm_phase<pg8::EpiQRope, pg8::StaticOrder, true, true>(lds + RING_OFF, g, S, E, wave); }
        __syncthreads();
        { pg8::Gemm g{PJ + C_BCKV, (const bf16*)(wb + WO_UKV), M, NKVB, KVL, NINP}; pg8::StaticOrder S; S.init(M, NKVB, G, (int)blockIdx.x);
          pg8::EpiRowScale E{KVM, NKVB, (const float*)(wsp() + WS_RSKV), 1.0f};
          pg8::gemm_phase<pg8::EpiRowScale, pg8::StaticOrder, true, true>(lds + RING_OFF, g, S, E, wave); }
    }
    SEAM(pb + 3);
    if (IN(pb + 4)) {
        naive_mlstm(kargs(), l, lds, tid);
        naive_window(kargs(), l, tid);
        naive_mla(kargs(), tid);
    }
    SEAM(pb + 4);
    if (IN(pb + 5)) mlstm_combine(kargs(), l, wave, lane);
    SEAM(pb + 5);
    if (IN(pb + 6)) {
        pg8::Gemm g{YC, (const bf16*)(wb + WO_OUT), M, DM, DM, DM}; pg8::StaticOrder S; S.init(M, DM, G, (int)blockIdx.x);
        pg8::EpiBf16 E{YB, DM};
        pg8::gemm_phase<pg8::EpiBf16, pg8::StaticOrder, true, true>(lds + RING_OFF, g, S, E, wave);
    }
    SEAM(pb + 6);
    if (IN(pb + 7)) {
        const float* gp = (const float*)kargs()->in[6] + l * DM; const float* g2 = (const float*)kargs()->in[7] + l * DM; const float* xi = (l == 0) ? x_in : xres; const int ln = lane;
        for (int m = gw; m < M; m += NGW) { const int b = m / SEQ; const float* mb = modl + (size_t)b * NMOD;
            row_norm(xi + (size_t)m * DM, YB + (size_t)m * DM, mb + 2 * DM, gp, xres + (size_t)m * DM, HB + (size_t)m * DM, g2, mb + 4 * DM, mb + 3 * DM, ln); }
    }
    SEAM(pb + 7);
    if (IN(pb + 8)) {
        pg8::Gemm g{HB, (const bf16*)(wb + WO_GU), M, 2 * DFF, DM, DM}; pg8::StaticOrder S; S.init(M, 2 * DFF, G, (int)blockIdx.x);
        pg8::EpiSwiGLU E{AB, DFF};
        pg8::gemm_phase<pg8::EpiSwiGLU, pg8::StaticOrder, true, true>(lds + RING_OFF, g, S, E, wave);
    }
    SEAM(pb + 8);
    if (IN(pb + 9)) {
        pg8::Gemm g{AB, (const bf16*)(wb + WO_DN), M, DM, DFF, DFF}; pg8::StaticOrder S; S.init(M, DM, G, (int)blockIdx.x);
        pg8::EpiBf16 E{YB, DM};
        pg8::gemm_phase<pg8::EpiBf16, pg8::StaticOrder, true, true>(lds + RING_OFF, g, S, E, wave);
    }
    SEAM(pb + 9);
    if (IN(pb + 10)) {
        constexpr bool nxt = (l + 1 < DEPTH); constexpr int ln1 = nxt ? l + 1 : l;
        const float* gp = (const float*)kargs()->in[8] + l * DM; const float* g1n = (const float*)kargs()->in[5] + ln1 * DM; const float* modn = modp + (size_t)ln1 * BATCH * NMOD; const int ln = lane;
        for (int m = gw; m < M; m += NGW) { const int b = m / SEQ; const float* mb = modl + (size_t)b * NMOD; const float* mbn = modn + (size_t)b * NMOD;
            row_norm(xres + (size_t)m * DM, YB + (size_t)m * DM, mb + 5 * DM, gp, xres + (size_t)m * DM, nxt ? HB + (size_t)m * DM : nullptr, g1n, mbn + 1 * DM, mbn + 0 * DM, ln); }
    }
    if (l + 1 < DEPTH) SEAM(pb + 10);
#undef wb
#undef modl
}

__global__ void __launch_bounds__(NTHR, 2) fwd_kernel(Args args) {
    extern __shared__ __attribute__((aligned(16))) unsigned char lds_raw[];
    LAS unsigned char* lds = (LAS unsigned char*)lds_raw;
    volatile LAS unsigned* MISC = (volatile LAS unsigned*)(lds + MISC_OFF);
    const int wave = __builtin_amdgcn_readfirstlane((int)threadIdx.x >> 6);
    unsigned* ctl = (unsigned*)(kargs()->ws + WS_CTL);
    for (int u = (int)threadIdx.x; u < (LDS_BYTES - LDSCTL_OFF) / 4; u += NTHR) ((LAS unsigned*)(lds + LDSCTL_OFF))[u] = 0u;
    __syncthreads();
    XcdBarrier bar; bar.bar = ctl + CW_BAR; bar.x = 0; bar.st = nullptr;
    if (MK_N_LAUNCHES == 1) bar = xcd_barrier_post(ctl + CW_BAR, MISC + 8, tid == 0);
#if MK_N_LAUNCHES == 1
    constexpr int lo = 0, hi = N_PHASES;
#else
    const int lo = kargs()->ph_lo, hi = kargs()->ph_hi;
#endif
    if (IN(0)) p0_prologue(kargs(), lds, wave, lane, tid);
    SEAM0(0);
    layer_phases<0>(lds, bar, wave, lo, hi);
    layer_phases<1>(lds, bar, wave, lo, hi);
}
#undef IN
#undef SEAM
#undef SEAM0
#undef lane
#undef tid
#undef gw

extern "C" void kernel_launch(void* const* d_in, const int* in_sizes, int n_in, void* d_out, int out_size, void* d_ws, size_t ws_size, hipStream_t stream) {
    static int grid = 0;
    if (grid == 0) {
        if (n_in != 21 || in_sizes[0] != M * DM || out_size != M * DM || ws_size < WS_END) { fprintf(stderr, "kernel_launch: unexpected shapes/workspace (n_in %d, in0 %d, out %d, ws %zu, need %zu)\n", n_in, n_in > 0 ? in_sizes[0] : -1, out_size, ws_size, (size_t)WS_END); grid = -1; return; }
        int dev = 0, cus = 0, per_cu = 0;
        if (hipGetDevice(&dev) != hipSuccess || hipDeviceGetAttribute(&cus, hipDeviceAttributeMultiprocessorCount, dev) != hipSuccess) { grid = -1; return; }
        if (hipFuncSetAttribute((const void*)fwd_kernel, hipFuncAttributeMaxDynamicSharedMemorySize, LDS_BYTES) != hipSuccess) { fprintf(stderr, "kernel_launch: hipFuncSetAttribute failed\n"); grid = -1; return; }
        if (hipOccupancyMaxActiveBlocksPerMultiprocessor(&per_cu, (const void*)fwd_kernel, NTHR, LDS_BYTES) != hipSuccess || per_cu < 1) fprintf(stderr, "kernel_launch: occupancy query reports %d\n", per_cu);
        (void)hipGetLastError();
        grid = cus;
    }
    if (grid < 0) return;
    (void)hipMemsetAsync((char*)d_ws + WS_CTL, 0, CTL_ZERO_BYTES, stream);
    Args a{};
    for (int i = 0; i < 21; ++i) a.in[i] = d_in[i];
    a.out = (float*)d_out; a.ws = (unsigned char*)d_ws;
    if (MK_N_LAUNCHES == 1) { a.ph_lo = 0; a.ph_hi = N_PHASES; hipLaunchKernelGGL(fwd_kernel, dim3(grid), dim3(NTHR), LDS_BYTES, stream, a); }
    else { for (int p = 0; p < N_PHASES; ++p) { a.ph_lo = p; a.ph_hi = p + 1; hipLaunchKernelGGL(fwd_kernel, dim3(grid), dim3(NTHR), LDS_BYTES, stream, a); } }
}
```

```cpp
#include <hip/hip_runtime.h>
#include <cstdio>
#include <cstdint>

constexpr int BATCH = 8, SEQ = 4096, DM = 2048, DEPTH = 2, M = BATCH * SEQ;
constexpr int NIN = 4240, NINP = 4352, DFF = 5632, NMOD = 6 * DM;
constexpr int C_AQ = 0, C_AK = 768, C_AV = 1024, C_BCQ = 1280, C_BCKV = 1728, C_BKR = 1856, C_CQ = 1920, C_CK = 2304, C_CV = 2688, C_CG = 3456, C_CO = 3472;
constexpr int QL = 448, QLP = 512, KVL = 128, NQB = 768, NKVB = 1024;
constexpr float EPS = 1e-6f;
constexpr float LOG2E = 1.4426950408889634f;
constexpr float QSCALE_A = 0.125f * 1.4426950408889634f;
constexpr float QSCALE_B = 0.10411754627697264f;
constexpr float QSCALE_C = 0.10206207261596575f;

namespace pg8 {
#define PG8_LAS __attribute__((address_space(3)))
typedef unsigned short bf16_t;
typedef short bf16x8 __attribute__((ext_vector_type(8)));
typedef float f32x4 __attribute__((ext_vector_type(4)));
typedef unsigned u32x4 __attribute__((ext_vector_type(4)));
constexpr int BM = 256, BK = 64, HALF = 128, HTB = HALF * BK * 2  , STAGE_BYTES = 8 * HTB, NXCD = 8, WGM = 8;

__host__ __device__ __forceinline__ int lds_byte(int r, int c) { const int st = (r >> 4) * 2 + (c >> 5), rr = r & 15, cc = c & 31, ob = rr * 64 + cc * 2; return st * 1024 + (ob ^ (((ob >> 9) & 1) << 5)); }
__host__ __device__ __forceinline__ void stage_rc(int b, int& R, int& C) { const int st = b / 1024, sb = b % 1024, swz = sb ^ (((sb >> 9) & 1) << 5); R = (st >> 1) * 16 + swz / 64; C = (st & 1) * 32 + (swz % 64) / 2; }
__host__ __device__ __forceinline__ int perm32(int rho) { const int n = rho >> 4, i = rho & 15; return 8 * (i >> 2) + 4 * n + (i & 3); }

struct Unit { int pm, pn; };
struct Gemm { const bf16_t* A; const bf16_t* Bt; int M, N, K, lda; };

struct StaticOrder {
    int nM, nN, nwg, G, c;
    __host__ __device__ void init(int M, int N, int G_, int c_) { nM = M / BM; nN = N / BM; nwg = nM * nN; G = G_; c = c_; }
    __host__ __device__ bool next(int i, Unit& u) const {
        const long L = (long)i * G + c; if (L >= nwg) return false;
        int wgid = (int)L; { const int q = nwg / NXCD, r = nwg % NXCD, xcd = wgid % NXCD, off = wgid / NXCD; wgid = (xcd < r ? xcd * (q + 1) : r * (q + 1) + (xcd - r) * q) + off; }
        const int nig = WGM * nN, gid = wgid / nig, fm = gid * WGM, gsz = (nM - fm) < WGM ? (nM - fm) : WGM;
        u.pm = fm + ((wgid % nig) % gsz); u.pn = (wgid % nig) / gsz; return true;
    }
    __device__ __forceinline__ void a_ready(const Unit&) const {}
    __device__ __forceinline__ void done(const Unit&) const {}
};


__device__ __forceinline__ unsigned cvt_pk_bf16(float lo, float hi) { unsigned r; asm volatile("v_cvt_pk_bf16_f32 %0, %1, %2" : "=v"(r) : "v"(lo), "v"(hi)); return r; }

struct EpiBf16 {
    static constexpr bool PERM = true, AFTER_DRAIN = false;
    bf16_t* O; int ldc;
    __device__ __forceinline__ void operator()(const f32x4 (&acc)[2][2][4][2], const Unit& u, int wr, int wc, int fr, int fq) const {
        const int row0 = u.pm * BM + wr * 64 + fr; const int col0 = u.pn * BM + wc * 32 + 8 * fq;
#pragma unroll
        for (int ai = 0; ai < 2; ++ai)
#pragma unroll
            for (int m = 0; m < 4; ++m) { unsigned off = (unsigned)(row0 + ai * HALF + m * 16) * (unsigned)ldc + (unsigned)col0; asm volatile("" : "+v"(off)); bf16_t* rowp = O + off;
#pragma unroll
                for (int bj = 0; bj < 2; ++bj) { const f32x4 v0 = acc[ai][bj][m][0], v1 = acc[ai][bj][m][1];
                    u32x4 w; w.x = cvt_pk_bf16(v0[0], v0[1]); w.y = cvt_pk_bf16(v0[2], v0[3]); w.z = cvt_pk_bf16(v1[0], v1[1]); w.w = cvt_pk_bf16(v1[2], v1[3]);
                    *(u32x4*)(rowp + bj * HALF) = w; } }
    }
};
struct EpiRowScale {
    static constexpr bool PERM = true, AFTER_DRAIN = false;
    bf16_t* O; int ldc; const float* rs; float mul;
    __device__ __forceinline__ void operator()(const f32x4 (&acc)[2][2][4][2], const Unit& u, int wr, int wc, int fr, int fq) const {
        const int row0 = u.pm * BM + wr * 64 + fr; const int col0 = u.pn * BM + wc * 32 + 8 * fq;
#pragma unroll
        for (int ai = 0; ai < 2; ++ai)
#pragma unroll
            for (int m = 0; m < 4; ++m) { int row = row0 + ai * HALF + m * 16; asm volatile("" : "+v"(row)); const float sc = rs[row] * mul; bf16_t* rowp = O + ((unsigned)row * (unsigned)ldc + (unsigned)col0);
#pragma unroll
                for (int bj = 0; bj < 2; ++bj) { const f32x4 v0 = acc[ai][bj][m][0] * sc, v1 = acc[ai][bj][m][1] * sc;
                    u32x4 w; w.x = cvt_pk_bf16(v0[0], v0[1]); w.y = cvt_pk_bf16(v0[2], v0[3]); w.z = cvt_pk_bf16(v1[0], v1[1]); w.w = cvt_pk_bf16(v1[2], v1[3]);
                    *(u32x4*)(rowp + bj * HALF) = w; } }
    }
};
struct EpiQRope {
    static constexpr bool PERM = true, AFTER_DRAIN = false;
    bf16_t* O; int ldc; const float* rs; float mul; const float* cs; const float* sn;
    __device__ __forceinline__ void operator()(const f32x4 (&acc)[2][2][4][2], const Unit& u, int wr, int wc, int fr, int fq) const {
        const int row0 = u.pm * BM + wr * 64 + fr; const int col0 = u.pn * BM + wc * 32 + 8 * fq;
#pragma unroll
        for (int ai = 0; ai < 2; ++ai)
#pragma unroll
            for (int m = 0; m < 4; ++m) { int row = row0 + ai * HALF + m * 16; asm volatile("" : "+v"(row)); const float sc = rs[row] * mul; bf16_t* rowp = O + ((unsigned)row * (unsigned)ldc + (unsigned)col0);
#pragma unroll
                for (int bj = 0; bj < 2; ++bj) { f32x4 v0 = acc[ai][bj][m][0] * sc, v1 = acc[ai][bj][m][1] * sc;
                    const int hc = (col0 + bj * HALF) % 192;
                    if (hc >= 128) { const int i0 = (hc - 128) >> 1; const f32x4 c = *(const f32x4*)(cs + (unsigned)(row * 32 + i0)), s = *(const f32x4*)(sn + (unsigned)(row * 32 + i0));
                        const f32x4 a = v0, b = v1;
                        v0[0] = a[0] * c[0] - a[1] * s[0]; v0[1] = a[0] * s[0] + a[1] * c[0]; v0[2] = a[2] * c[1] - a[3] * s[1]; v0[3] = a[2] * s[1] + a[3] * c[1];
                        v1[0] = b[0] * c[2] - b[1] * s[2]; v1[1] = b[0] * s[2] + b[1] * c[2]; v1[2] = b[2] * c[3] - b[3] * s[3]; v1[3] = b[2] * s[3] + b[3] * c[3]; }
                    u32x4 w; w.x = cvt_pk_bf16(v0[0], v0[1]); w.y = cvt_pk_bf16(v0[2], v0[3]); w.z = cvt_pk_bf16(v1[0], v1[1]); w.w = cvt_pk_bf16(v1[2], v1[3]);
                    *(u32x4*)(rowp + bj * HALF) = w; } }
    }
};
struct EpiSwiGLU {
    static constexpr bool PERM = true, AFTER_DRAIN = false;
    bf16_t* O; int ldc;
    __device__ __forceinline__ void operator()(const f32x4 (&acc)[2][2][4][2], const Unit& u, int wr, int wc, int fr, int fq) const {
        const int row0 = u.pm * BM + wr * 64 + fr; const int col0 = u.pn * HALF + wc * 32 + 8 * fq;
#pragma unroll
        for (int ai = 0; ai < 2; ++ai)
#pragma unroll
            for (int m = 0; m < 4; ++m) { unsigned off = (unsigned)(row0 + ai * HALF + m * 16) * (unsigned)ldc + (unsigned)col0; asm volatile("" : "+v"(off)); bf16_t* rowp = O + off;
                float o[8];
#pragma unroll
                for (int n = 0; n < 2; ++n)
#pragma unroll
                    for (int j = 0; j < 4; ++j) { const float g = acc[ai][0][m][n][j], up = acc[ai][1][m][n][j];
                        const float e = __builtin_amdgcn_exp2f(-g * 1.4426950408889634f); o[n * 4 + j] = g * __builtin_amdgcn_rcpf(1.0f + e) * up; }
                u32x4 w; w.x = cvt_pk_bf16(o[0], o[1]); w.y = cvt_pk_bf16(o[2], o[3]); w.z = cvt_pk_bf16(o[4], o[5]); w.w = cvt_pk_bf16(o[6], o[7]);
                *(u32x4*)rowp = w; }
    }
};

template <class Epi, class Sched, bool ALIGN_EPI = false, bool SP2 = false>
__device__ __forceinline__ void gemm_phase(PG8_LAS unsigned char* lds, const Gemm g, const Sched& S, const Epi& E, const int wave_id) {
    int lane_ = (int)__builtin_amdgcn_mbcnt_hi(~0u, __builtin_amdgcn_mbcnt_lo(~0u, 0u)); asm volatile("" : "+v"(lane_));
    const int wid = wave_id, lane = lane_, tid = wid * 64 + lane, wr = wid >> 2, wc = wid & 3, fr = lane & 15, fq = lane >> 4;
    const int K = g.K, nt = K / BK;
    unsigned voffA[2], voffB[2];
#pragma unroll
    for (int i = 0; i < 2; ++i) { int R, C; stage_rc(tid * 16 + i * 8192, R, C); const int Rb = Epi::PERM ? ((R & ~31) + perm32(R & 31)) : R;
        voffA[i] = (unsigned)(R * g.lda + C) * 2u; voffB[i] = (unsigned)(Rb * K + C) * 2u; }
    const size_t kstep = (size_t)(BK * 2);
    const size_t hstepA = (size_t)HALF * g.lda * 2, hstepB = (size_t)HALF * K * 2;
    const size_t tstepA = 2 * hstepA, tstepB = 2 * hstepB;
    const unsigned ldsw = (unsigned)wid * 1024u;
    const int aoff = lds_byte(wr * 64 + fr, fq * 8), boff = lds_byte(wc * 32 + fr, fq * 8);
#define PG8_SA(b, h) (((b) * 2 + (h)) * HTB)
#define PG8_SB(b, h) ((4 + (b) * 2 + (h)) * HTB)
#define PG8_STAGE(bufoff, gbase, voff) do { _Pragma("unroll") for (int _i = 0; _i < 2; ++_i) \
        __builtin_amdgcn_global_load_lds((const unsigned*)((const char*)(gbase) + (voff)[_i]), (PG8_LAS unsigned*)(lds + (bufoff) + ldsw + _i * 8192), 16, 0, 0); } while (0)
#define PG8_LDA(dst, b, h) do { _Pragma("unroll") for (int m = 0; m < 4; ++m) _Pragma("unroll") for (int k = 0; k < 2; ++k) dst[m][k] = *(const PG8_LAS bf16x8*)(lds + PG8_SA(b, h) + aoff + m * 2048 + k * 1024); } while (0)
#define PG8_LDB(dst, b, h) do { _Pragma("unroll") for (int n = 0; n < 2; ++n) _Pragma("unroll") for (int k = 0; k < 2; ++k) dst[n][k] = *(const PG8_LAS bf16x8*)(lds + PG8_SB(b, h) + boff + n * 2048 + k * 1024); } while (0)
#define PG8_MMA(ai, bj, At, Bt) do { __builtin_amdgcn_s_setprio(1); _Pragma("unroll") for (int m = 0; m < 4; ++m) _Pragma("unroll") for (int n = 0; n < 2; ++n) _Pragma("unroll") for (int k = 0; k < 2; ++k) \
        acc[ai][bj][m][n] = __builtin_amdgcn_mfma_f32_16x16x32_bf16(Bt[n][k], At[m][k], acc[ai][bj][m][n], 0, 0, 0); __builtin_amdgcn_s_setprio(0); } while (0)
#define PG8_WAIT_V(n) asm volatile("s_waitcnt vmcnt(" #n ")" ::: "memory")
#define PG8_WAIT_L(n) asm volatile("s_waitcnt lgkmcnt(" #n ")" ::: "memory")
#define PG8_BAR __builtin_amdgcn_s_barrier()
#define PG8_SCHED __builtin_amdgcn_sched_barrier(0)
    Unit cur, nxt; int ui = 0;
    if (!S.next(0, cur)) return;
    f32x4 acc[2][2][4][2];
#pragma unroll
    for (int a = 0; a < 2; ++a)
#pragma unroll
        for (int b = 0; b < 2; ++b)
#pragma unroll
            for (int m = 0; m < 4; ++m)
#pragma unroll
                for (int n = 0; n < 2; ++n) acc[a][b][m][n] = (f32x4){0.f, 0.f, 0.f, 0.f};
    bf16x8 At[4][2], B0[2][2], B1[2][2];
    const char* cA = (const char*)g.A + (size_t)cur.pm * tstepA; const char* cB = (const char*)g.Bt + (size_t)cur.pn * tstepB;
    S.a_ready(cur);
    if constexpr (SP2) {
        PG8_STAGE(PG8_SB(0, 0), cB, voffB); PG8_STAGE(PG8_SB(0, 1), cB + hstepB, voffB); PG8_STAGE(PG8_SA(0, 0), cA, voffA); PG8_STAGE(PG8_SA(0, 1), cA + hstepA, voffA);
        if (wr == 1) PG8_BAR;
        PG8_WAIT_V(2); PG8_BAR;
        PG8_STAGE(PG8_SB(1, 0), cB + kstep, voffB); PG8_STAGE(PG8_SA(1, 0), cA + kstep, voffA); PG8_STAGE(PG8_SB(1, 1), cB + hstepB + kstep, voffB);
        PG8_WAIT_V(6); PG8_BAR;
    } else {
        PG8_STAGE(PG8_SB(0, 0), cB, voffB); PG8_STAGE(PG8_SA(0, 0), cA, voffA); PG8_STAGE(PG8_SB(0, 1), cB + hstepB, voffB); PG8_STAGE(PG8_SA(0, 1), cA + hstepA, voffA);
        if (wr == 1) PG8_BAR;
        PG8_WAIT_V(4); PG8_BAR;
        PG8_STAGE(PG8_SB(1, 0), cB + kstep, voffB); PG8_STAGE(PG8_SA(1, 0), cA + kstep, voffA); PG8_STAGE(PG8_SB(1, 1), cB + hstepB + kstep, voffB);
        PG8_WAIT_V(6); PG8_BAR;
    }
    for (;;) {
        const bool has_next = S.next(ui + 1, nxt);
        const char* nA = has_next ? (const char*)g.A + (size_t)nxt.pm * tstepA : cA; const char* nB = has_next ? (const char*)g.Bt + (size_t)nxt.pn * tstepB : cB;
        for (int t = 0; t < nt; t += 2) {
            const bool last = (t == nt - 2);
            const char* a1 = cA + (size_t)(t + 1) * kstep;
            const char* a2 = last ? nA : cA + (size_t)(t + 2) * kstep; const char* b2 = last ? nB : cB + (size_t)(t + 2) * kstep;
            const char* a3 = a2 + kstep; const char* b3 = b2 + kstep;
            if (last && has_next) S.a_ready(nxt);
            if constexpr (SP2) {
            PG8_LDB(B0, 0, 0); PG8_LDB(B1, 0, 1); PG8_SCHED; PG8_LDA(At, 0, 0); PG8_STAGE(PG8_SA(1, 1), a1 + hstepA, voffA);
            PG8_WAIT_V(8); PG8_WAIT_L(0); PG8_BAR; PG8_MMA(0, 0, At, B0); PG8_MMA(0, 1, At, B1); PG8_BAR; PG8_SCHED;
            PG8_LDA(At, 0, 1); PG8_STAGE(PG8_SB(0, 0), b2, voffB); PG8_STAGE(PG8_SB(0, 1), b2 + hstepB, voffB); PG8_STAGE(PG8_SA(0, 0), a2, voffA);
            PG8_WAIT_V(8); PG8_WAIT_L(0); PG8_BAR; PG8_MMA(1, 0, At, B0); PG8_MMA(1, 1, At, B1); PG8_BAR; PG8_SCHED;
            PG8_LDB(B0, 1, 0); PG8_LDB(B1, 1, 1); PG8_SCHED; PG8_LDA(At, 1, 0); PG8_STAGE(PG8_SA(0, 1), a2 + hstepA, voffA);
            PG8_WAIT_V(8); PG8_WAIT_L(0); PG8_BAR; PG8_MMA(0, 0, At, B0); PG8_MMA(0, 1, At, B1); PG8_BAR; PG8_SCHED;
            PG8_LDA(At, 1, 1); PG8_STAGE(PG8_SB(1, 0), b3, voffB); PG8_STAGE(PG8_SB(1, 1), b3 + hstepB, voffB); PG8_STAGE(PG8_SA(1, 0), a3, voffA);
            PG8_WAIT_V(8); PG8_WAIT_L(0); PG8_BAR; PG8_MMA(1, 0, At, B0); PG8_MMA(1, 1, At, B1); PG8_BAR; PG8_SCHED;
            } else {
            PG8_LDB(B0, 0, 0); PG8_SCHED; PG8_LDA(At, 0, 0); PG8_STAGE(PG8_SA(1, 1), a1 + hstepA, voffA);
            PG8_WAIT_L(8); PG8_BAR; PG8_WAIT_L(0); PG8_MMA(0, 0, At, B0); PG8_BAR; PG8_SCHED;
            PG8_LDB(B1, 0, 1); PG8_STAGE(PG8_SB(0, 0), b2, voffB);
            PG8_BAR; PG8_WAIT_L(0); PG8_MMA(0, 1, At, B1); PG8_BAR;
            PG8_LDA(At, 0, 1); PG8_STAGE(PG8_SA(0, 0), a2, voffA);
            PG8_BAR; PG8_WAIT_L(0); PG8_MMA(1, 0, At, B0); PG8_BAR; PG8_SCHED;
            PG8_STAGE(PG8_SB(0, 1), b2 + hstepB, voffB);
            PG8_WAIT_V(6); PG8_BAR; PG8_MMA(1, 1, At, B1); PG8_BAR;
            PG8_LDB(B0, 1, 0); PG8_SCHED; PG8_LDA(At, 1, 0); PG8_STAGE(PG8_SA(0, 1), a2 + hstepA, voffA);
            PG8_WAIT_L(8); PG8_BAR; PG8_WAIT_L(0); PG8_MMA(0, 0, At, B0); PG8_BAR; PG8_SCHED;
            PG8_LDB(B1, 1, 1); PG8_STAGE(PG8_SB(1, 0), b3, voffB);
            PG8_BAR; PG8_WAIT_L(0); PG8_MMA(0, 1, At, B1); PG8_BAR;
            PG8_LDA(At, 1, 1); PG8_STAGE(PG8_SA(1, 0), a3, voffA);
            PG8_BAR; PG8_WAIT_L(0); PG8_MMA(1, 0, At, B0); PG8_BAR; PG8_SCHED;
            PG8_STAGE(PG8_SB(1, 1), b3 + hstepB, voffB);
            PG8_WAIT_V(6); PG8_BAR; PG8_MMA(1, 1, At, B1); PG8_BAR;
            }
        }
        if constexpr (ALIGN_EPI) { if (wr == 0) PG8_BAR; }
        if constexpr (!Epi::AFTER_DRAIN) { E(acc, cur, wr, wc, fr, fq); S.done(cur); }
        if (!has_next) break;
#pragma unroll
        for (int a = 0; a < 2; ++a)
#pragma unroll
            for (int b = 0; b < 2; ++b)
#pragma unroll
                for (int m = 0; m < 4; ++m)
#pragma unroll
                    for (int n = 0; n < 2; ++n) acc[a][b][m][n] = (f32x4){0.f, 0.f, 0.f, 0.f};
        cur = nxt; cA = nA; cB = nB; ++ui;
        if constexpr (ALIGN_EPI) { if (wr == 1) PG8_BAR; }
    }
    PG8_WAIT_V(0);
    if constexpr (!ALIGN_EPI) { if (wr == 0) PG8_BAR; }
    PG8_BAR;
    if constexpr (Epi::AFTER_DRAIN) { E.fused(acc, cur, wr, wc, fr, fq, lds, wid, lane); S.done(cur); }
#undef PG8_SA
#undef PG8_SB
#undef PG8_STAGE
#undef PG8_LDA
#undef PG8_LDB
#undef PG8_MMA
#undef PG8_WAIT_V
#undef PG8_WAIT_L
#undef PG8_BAR
#undef PG8_SCHED
}
}
#define GAS __attribute__((address_space(1)))
#define LAS __attribute__((address_space(3)))
typedef unsigned short bf16;
typedef unsigned v4u __attribute__((ext_vector_type(4)));
typedef float f32x4 __attribute__((ext_vector_type(4)));
typedef short bf16x8 __attribute__((ext_vector_type(8)));
typedef unsigned v2u __attribute__((ext_vector_type(2)));
typedef GAS unsigned gu32;
typedef GAS unsigned long long gu64;
#define RLX_AGENT __ATOMIC_RELAXED, __HIP_MEMORY_SCOPE_AGENT
#define LDS_WAIT() asm volatile("s_waitcnt lgkmcnt(0)" ::: "memory")
#define VM_WAIT() asm volatile("s_waitcnt vmcnt(0)" ::: "memory")
__device__ __forceinline__ unsigned long long rt() { return __builtin_amdgcn_s_memrealtime(); }
__device__ __forceinline__ unsigned f2bf(float f) { unsigned u = __builtin_bit_cast(unsigned, f); return (u + 0x7fffu + ((u >> 16) & 1u)) >> 16; }
__device__ __forceinline__ unsigned pk2(float lo, float hi) { return f2bf(lo) | (f2bf(hi) << 16); }
#define XB_TMO      128
#define XB_XCNT(j)  (256  + 64 * (j))
#define XB_XSUB(j)  (1280 + 64 * (j))
#define XB_XGEN(j)  (2304 + 64 * (j))
#define XB_TOP      3328
#define XB_TOPGEN   3392
#define XCD_BAR_WORDS 3456
#define XB_SPIN_CAP (1u << 18)

__device__ __forceinline__ unsigned xb_ld(unsigned* p)              { return __hip_atomic_load(p, __ATOMIC_RELAXED, __HIP_MEMORY_SCOPE_AGENT); }
__device__ __forceinline__ unsigned xb_add(unsigned* p, unsigned v) { return __hip_atomic_fetch_add(p, v, __ATOMIC_RELAXED, __HIP_MEMORY_SCOPE_AGENT); }
__device__ __forceinline__ unsigned xb_xcc_id() { return (unsigned)__builtin_amdgcn_s_getreg((3 << 11) | 20) & 0xFu; }
#define XB_SPIN(cond, bar) do { unsigned _sp = 0; while (cond) { __builtin_amdgcn_s_sleep(1); \
    if ((++_sp & 255u) == 0u) { if (xb_ld(&(bar)[XB_TMO])) break; if (_sp > XB_SPIN_CAP) { atomicAdd(&(bar)[XB_TMO], 1u); break; } } } } while (0)

struct XcdBarrier {
    unsigned* bar; unsigned x;
    volatile LAS unsigned* st;
};

__device__ __forceinline__ XcdBarrier xcd_barrier_post(unsigned* bar, volatile LAS unsigned* st, const bool t0) {
    XcdBarrier b; b.bar = bar; b.x = xb_xcc_id(); b.st = st;
    if (t0) (void)xb_add(&bar[XB_XCNT(b.x)], 1u);
    return b;
}
__device__ __forceinline__ void xcd_barrier_complete(unsigned* bar, unsigned x, unsigned& nloc, unsigned& nx) {
    const unsigned G = gridDim.x * gridDim.y * gridDim.z;
    unsigned sum, cnt, mine, sp = 0u;
    for (;;) {
        sum = 0u; cnt = 0u; mine = 0u;
#pragma unroll
        for (unsigned j = 0; j < 16; ++j) { const unsigned c = xb_ld(&bar[XB_XCNT(j)]); sum += c; cnt += (c > 0u) ? 1u : 0u; mine = (j == x) ? c : mine; }
        if (sum == G) break;
        __builtin_amdgcn_s_sleep(1);
        if ((++sp & 255u) == 0u) { if (xb_ld(&bar[XB_TMO])) break; if (sp > XB_SPIN_CAP) { atomicAdd(&bar[XB_TMO], 1u); break; } }
    }
    nloc = mine > 0u ? mine : 1u; nx = cnt > 0u ? cnt : 1u;
}

template <bool FIRST> __device__ __forceinline__ void xcd_barrier(const XcdBarrier& b, const bool t0) {
    asm volatile("s_waitcnt vmcnt(0)" ::: "memory");
    __syncthreads();
    if (t0) {
        unsigned* bar = b.bar; unsigned bx = b.x; asm volatile("" : "+s"(bar), "+s"(bx));
        __builtin_amdgcn_s_waitcnt(0);
        unsigned nloc = b.st[0], nx = b.st[1];
        if constexpr (FIRST) { if (nloc == 0u) { xcd_barrier_complete(bar, bx, nloc, nx); b.st[0] = nloc; b.st[1] = nx; } }
        const unsigned old = xb_add(&bar[XB_XSUB(bx)], 1u);
        const unsigned gen = old / nloc;
        if (old + 1u == (gen + 1u) * nloc) {
            __builtin_amdgcn_fence(__ATOMIC_RELEASE, "agent");
            asm volatile("s_waitcnt vmcnt(0)" ::: "memory");
            const unsigned og = xb_add(&bar[XB_TOP], 1u);
            const unsigned tg = og / nx;
            if (og + 1u == (tg + 1u) * nx) xb_add(&bar[XB_TOPGEN], 1u);
            else XB_SPIN(xb_ld(&bar[XB_TOPGEN]) == tg, bar);
            __builtin_amdgcn_fence(__ATOMIC_ACQUIRE, "agent");
            xb_add(&bar[XB_XGEN(bx)], 1u);
            asm volatile("s_waitcnt vmcnt(0)" ::: "memory");
        } else {
            XB_SPIN(xb_ld(&bar[XB_XGEN(bx)]) == gen, bar);
            __builtin_amdgcn_fence(__ATOMIC_ACQUIRE, "agent");
            asm volatile("s_waitcnt vmcnt(0)" ::: "memory");
        }
    }
    __syncthreads();
}

constexpr size_t MiB = 1u << 20;
constexpr size_t WS_CTL = 0, CTL_ZERO_BYTES = 1 * MiB;
constexpr size_t WS_MOD = 1 * MiB;
constexpr size_t WS_COS = 2 * MiB, WS_SIN = 6 * MiB;
constexpr size_t WS_RSQ = 10 * MiB, WS_RSKV = 10 * MiB + 512 * 1024;
constexpr size_t WS_KROPE = 11 * MiB;
constexpr size_t WS_GPREP = 15 * MiB;
constexpr size_t WS_W = 24 * MiB, W_LAYER = 92 * MiB;
constexpr size_t WO_IN = 0, WO_UQ = 17 * MiB, WO_UKV = 17 * MiB + 768 * 1024, WO_OUT = 18 * MiB, WO_GU = 26 * MiB, WO_DN = 70 * MiB;
constexpr size_t WS_HBUF = 208 * MiB;
constexpr size_t WS_YBUF = 336 * MiB;
constexpr size_t WS_YCAT = WS_HBUF;
constexpr size_t WS_XR = 464 * MiB;
constexpr size_t WS_PROJ = 592 * MiB;
constexpr size_t WS_QMLA = 864 * MiB;
constexpr size_t WS_KVMLA = 912 * MiB;
constexpr size_t WS_ABUF = WS_PROJ;
constexpr size_t WS_END = 976 * MiB;
static_assert(WS_W + 2 * W_LAYER <= WS_HBUF && WS_XR + (size_t)M * DM * 2 <= WS_PROJ && WS_ABUF + (size_t)M * DFF * 2 <= WS_END && (size_t)2 * M * 768 * 4 <= (size_t)M * DM * 4, "d_ws map");
static_assert(WO_IN + (size_t)NINP * DM * 2 <= WO_UQ && WO_UQ + (size_t)NQB * QLP * 2 <= WO_UKV && WO_UKV + (size_t)NKVB * KVL * 2 <= WO_OUT && WO_OUT + (size_t)DM * DM * 2 <= WO_GU && WO_GU + (size_t)2 * DFF * DM * 2 <= WO_DN && WO_DN + (size_t)DM * DFF * 2 <= W_LAYER, "weight map");
constexpr int CW_BAR = 4096;
constexpr int CW_Q = 16384;

constexpr int RING_OFF = 0, RING_BYTES = 131072;
constexpr int LDSCTL_OFF = RING_BYTES, MISC_OFF = LDSCTL_OFF + 320;
constexpr int LDS_BYTES = 147456;
constexpr int NWAVES = 8, NTHR = 512;

__device__ __forceinline__ float wave_sum(float v) {
#pragma unroll
    for (int o = 1; o < 64; o <<= 1) v += __shfl_xor(v, o);
    return v;
}
__device__ __forceinline__ float bf2f(unsigned short b) { return __builtin_bit_cast(float, (unsigned)b << 16); }
__device__ __forceinline__ float bflo(unsigned w) { return __builtin_bit_cast(float, w << 16); }
__device__ __forceinline__ float bfhi(unsigned w) { return __builtin_bit_cast(float, w & 0xffff0000u); }

__constant__ double INVF[32] = {1.0, 0.7498942093324559, 0.5623413251903491, 0.4216965034285822, 0.31622776601683794, 0.23713737056616552, 0.1778279410038923, 0.1333521432163324, 0.1, 0.07498942093324558, 0.05623413251903491, 0.042169650342858224, 0.03162277660168379, 0.023713737056616554, 0.01778279410038923, 0.01333521432163324, 0.01, 0.007498942093324558, 0.005623413251903491, 0.004216965034285823, 0.0031622776601683794, 0.0023713737056616554, 0.0017782794100389228, 0.001333521432163324, 0.001, 0.0007498942093324559, 0.0005623413251903491, 0.00042169650342858224, 0.00031622776601683794, 0.00023713737056616554, 0.00017782794100389227, 0.0001333521432163324};
__constant__ float ALIBI[12] = {0.5f, 0.25f, 0.125f, 0.0625f, 0.03125f, 0.015625f, 0.0078125f, 0.00390625f, 0.7071067690849304f, 0.3535533845424652f, 0.1767766922712326f, 0.0883883461356163f};

__device__ __forceinline__ int lane_id() { int l = (int)__builtin_amdgcn_mbcnt_hi(~0u, __builtin_amdgcn_mbcnt_lo(~0u, 0u)); asm volatile("" : "+v"(l)); return l; }
struct Args { const void* in[21]; float* out; unsigned char* ws; int ph_lo, ph_hi; };
typedef const __attribute__((address_space(4))) Args* KArgs;
__device__ __forceinline__ KArgs kargs() { KArgs p = (KArgs)__builtin_amdgcn_kernarg_segment_ptr(); asm volatile("" : "+s"(p)); return p; }

enum { WK_IN = 0, WK_UQ, WK_UKV, WK_OUT, WK_GATE, WK_UP, WK_DN };
__device__ __forceinline__ int wk_row(int kind, int n) {
    if (kind == WK_UQ) { const int hd = n / 192, hc = n % 192; if (hc < 128) return n; const int i = hc - 128; return hd * 192 + 128 + (i < 32 ? 2 * i : 2 * (i - 32) + 1); }
    if (kind == WK_GATE) return (n >> 7) * 256 + (n & 127);
    if (kind == WK_UP) return (n >> 7) * 256 + 128 + (n & 127);
    return n;
}
__device__ __forceinline__ float wk_colscale(int kind, int n) {
    if (kind == WK_IN) { if (n < C_AK) return QSCALE_A; if (n >= C_CQ && n < C_CK) return QSCALE_C; }
    return 1.0f;
}
__device__ __forceinline__ void transpose_item(const float* W, int K, int N, bf16* WT, int ldt, int kind, const float* rowg, LAS float* scr, int item, int lane) {
    const int nblk = (N + 31) / 32, kb = item / nblk, nb = item % nblk, k0 = 64 * kb, n0 = 32 * nb;
    { const int c4 = lane & 7, rr = lane >> 3, n = n0 + 4 * c4; f32x4 v[8];
#pragma unroll
      for (int i = 0; i < 8; ++i) { v[i] = (f32x4){0.f, 0.f, 0.f, 0.f}; if (n < N) v[i] = *(const GAS f32x4*)(W + (size_t)(k0 + 8 * i + rr) * N + n); }
      const float c0 = wk_colscale(kind, n), c1 = wk_colscale(kind, n + 1), c2 = wk_colscale(kind, n + 2), c3 = wk_colscale(kind, n + 3);
#pragma unroll
      for (int i = 0; i < 8; ++i) { const int kk = 8 * i + rr; const float g = rowg ? rowg[k0 + kk] : 1.0f; LAS float* d = scr + kk * 33 + 4 * c4;
          d[0] = v[i][0] * c0 * g; d[1] = v[i][1] * c1 * g; d[2] = v[i][2] * c2 * g; d[3] = v[i][3] * c3 * g; } }
    LDS_WAIT(); asm volatile("" ::: "memory");
    const int c = lane & 7;
#pragma unroll
    for (int j = 0; j < 4; ++j) { const int nl = (lane >> 3) + 8 * j; const LAS float* s = scr + (8 * c) * 33 + nl; const int drow = wk_row(kind, n0 + nl);
        v4u o; o.x = pk2(s[0 * 33], s[1 * 33]); o.y = pk2(s[2 * 33], s[3 * 33]); o.z = pk2(s[4 * 33], s[5 * 33]); o.w = pk2(s[6 * 33], s[7 * 33]);
        *(GAS v4u*)(WT + (size_t)drow * ldt + k0 + 8 * c) = o; }
    LDS_WAIT(); asm volatile("" ::: "memory");
}
__device__ __forceinline__ void sincos_rev(double r, float& sn, float& cs) {
    const double k = __builtin_rint(4.0 * r); const double f = r - 0.25 * k; const double y = 6.283185307179586476925 * f; const double y2 = y * y;
    double s = y * (1.0 + y2 * (-1.0 / 6 + y2 * (1.0 / 120 + y2 * (-1.0 / 5040 + y2 * (1.0 / 362880 + y2 * (-1.0 / 39916800 + y2 * (1.0 / 6227020800.0)))))));
    double c = 1.0 + y2 * (-0.5 + y2 * (1.0 / 24 + y2 * (-1.0 / 720 + y2 * (1.0 / 40320 + y2 * (-1.0 / 3628800 + y2 * (1.0 / 479001600.0 + y2 * (-1.0 / 87178291200.0)))))));
    const int q = ((int)k) & 3; double ss, cc;
    if (q == 0) { ss = s; cc = c; } else if (q == 1) { ss = c; cc = -s; } else if (q == 2) { ss = -s; cc = -c; } else { ss = -c; cc = s; }
    sn = (float)ss; cs = (float)cc;
}

struct RowRegs { f32x4 xf[8]; v2u xb[8]; v2u y[8]; };
template <bool XIN_F32, bool HAS_BR> __device__ __forceinline__ void row_load(RowRegs& R, const void* xin, const bf16* br, int lane) {
    if (XIN_F32) {
#pragma unroll
        for (int j = 0; j < 8; ++j) R.xf[j] = __builtin_nontemporal_load((const GAS f32x4*)((const float*)xin + 4 * (64 * j + lane)));
    } else {
#pragma unroll
        for (int j = 0; j < 8; ++j) R.xb[j] = __builtin_nontemporal_load((const GAS v2u*)((const bf16*)xin + 4 * (64 * j + lane)));
    }
    if (HAS_BR) {
#pragma unroll
        for (int j = 0; j < 8; ++j) R.y[j] = __builtin_nontemporal_load((const GAS v2u*)(br + 4 * (64 * j + lane)));
    }
}
template <bool XIN_F32, bool XOUT_F32, bool HAS_BR, bool HAS_X, bool HAS_H>
__device__ __forceinline__ void row_compute(const RowRegs& R, const LAS float* cst, void* xout, bf16* hout, int lane) {
    f32x4 v[8];
    if (XIN_F32) {
#pragma unroll
        for (int j = 0; j < 8; ++j) v[j] = R.xf[j];
    } else {
#pragma unroll
        for (int j = 0; j < 8; ++j) v[j] = (f32x4){bflo(R.xb[j].x), bfhi(R.xb[j].x), bflo(R.xb[j].y), bfhi(R.xb[j].y)};
    }
    if (HAS_BR) {
        f32x4 y[8]; float ss = 0.f;
#pragma unroll
        for (int j = 0; j < 8; ++j) { y[j] = (f32x4){bflo(R.y[j].x), bfhi(R.y[j].x), bflo(R.y[j].y), bfhi(R.y[j].y)}; ss += (y[j][0] * y[j][0] + y[j][1] * y[j][1]) + (y[j][2] * y[j][2] + y[j][3] * y[j][3]); }
        const float rstd = 1.0f / sqrtf(wave_sum(ss) * (1.0f / DM) + EPS);
#pragma unroll
        for (int j = 0; j < 8; ++j) v[j] = v[j] + *(const LAS f32x4*)(cst + 4 * (64 * j + lane)) * (y[j] * rstd);
    }
    if (HAS_X) {
        if (XOUT_F32) {
#pragma unroll
            for (int j = 0; j < 8; ++j) __builtin_nontemporal_store(v[j], (GAS f32x4*)((float*)xout + 4 * (64 * j + lane)));
        } else {
#pragma unroll
            for (int j = 0; j < 8; ++j) { v2u w; w.x = pk2(v[j][0], v[j][1]); w.y = pk2(v[j][2], v[j][3]); *(GAS v2u*)((bf16*)xout + 4 * (64 * j + lane)) = w;
                v[j] = (f32x4){bflo(w.x), bfhi(w.x), bflo(w.y), bfhi(w.y)}; }
        }
    }
    if (HAS_H) {
        float ss = 0.f;
#pragma unroll
        for (int j = 0; j < 8; ++j) ss += (v[j][0] * v[j][0] + v[j][1] * v[j][1]) + (v[j][2] * v[j][2] + v[j][3] * v[j][3]);
        const float rstd = 1.0f / sqrtf(wave_sum(ss) * (1.0f / DM) + EPS);
#pragma unroll
        for (int j = 0; j < 8; ++j) { const f32x4 h = v[j] * rstd * *(const LAS f32x4*)(cst + DM + 4 * (64 * j + lane)) + *(const LAS f32x4*)(cst + 2 * DM + 4 * (64 * j + lane));
            v2u w; w.x = pk2(h[0], h[1]); w.y = pk2(h[2], h[3]); *(GAS v2u*)(hout + 4 * (64 * j + lane)) = w; }
    }
}
template <bool XIN_F32, bool XOUT_F32, bool HAS_BR, bool HAS_X, bool HAS_H>
__device__ __forceinline__ void row_norm_wg(LAS unsigned char* lds, const void* xin, const bf16* br, const float* gate, const float* gpost, void* xout, bf16* hout, const float* gpre, const float* scale, const float* shift, int row0, int wave, int lane) {
    LAS float* cst = (LAS float*)lds;
    __syncthreads();
    { const int c = 4 * (wave * 64 + lane);
      if (HAS_BR) *(LAS f32x4*)(cst + c) = *(const GAS f32x4*)(gate + c) * *(const GAS f32x4*)(gpost + c);
      if (HAS_H) { *(LAS f32x4*)(cst + DM + c) = *(const GAS f32x4*)(gpre + c) * (*(const GAS f32x4*)(scale + c) + 1.0f); *(LAS f32x4*)(cst + 2 * DM + c) = *(const GAS f32x4*)(shift + c); } }
    const int m0 = row0 + wave * 16;
    const size_t xs = XIN_F32 ? 4 : 2, os = XOUT_F32 ? 4 : 2;
    if (XIN_F32) {
        RowRegs A;
        __syncthreads();
#pragma unroll 1
        for (int r = 0; r < 16; ++r) { const size_t ma = (size_t)(m0 + r);
            row_load<XIN_F32, HAS_BR>(A, (const char*)xin + ma * DM * xs, br + ma * DM, lane);
            row_compute<XIN_F32, XOUT_F32, HAS_BR, HAS_X, HAS_H>(A, cst, (char*)xout + ma * DM * os, hout + ma * DM, lane); }
    } else {
        RowRegs A, B;
        row_load<XIN_F32, HAS_BR>(A, (const char*)xin + (size_t)m0 * DM * xs, br + (size_t)m0 * DM, lane);
        __syncthreads();
#pragma unroll 1
        for (int r = 0; r < 16; r += 2) {
            const size_t ma = (size_t)(m0 + r), mb = ma + 1, mc = ma + 2;
            row_load<XIN_F32, HAS_BR>(B, (const char*)xin + mb * DM * xs, br + mb * DM, lane);
            row_compute<XIN_F32, XOUT_F32, HAS_BR, HAS_X, HAS_H>(A, cst, (char*)xout + ma * DM * os, hout + ma * DM, lane);
            if (r + 2 < 16) row_load<XIN_F32, HAS_BR>(A, (const char*)xin + mc * DM * xs, br + mc * DM, lane);
            row_compute<XIN_F32, XOUT_F32, HAS_BR, HAS_X, HAS_H>(B, cst, (char*)xout + mb * DM * os, hout + mb * DM, lane);
        }
    }
}

struct WDesc { const float* W; int K, N; bf16* WT; int ldt, kind; const float* rowg; int nitems; };
__device__ __forceinline__ void wdesc_layer(KArgs a, int l, WDesc (&d)[7]) {
    unsigned char* wb = a->ws + WS_W + (size_t)l * W_LAYER;
    d[0] = WDesc{(const float*)a->in[9] + (size_t)l * DM * NIN, DM, NIN, (bf16*)(wb + WO_IN), DM, WK_IN, nullptr, 0};
    d[1] = WDesc{(const float*)a->in[12] + (size_t)l * QL * NQB, QL, NQB, (bf16*)(wb + WO_UQ), QLP, WK_UQ, (const float*)a->in[11] + l * QL, 0};
    d[2] = WDesc{(const float*)a->in[14] + (size_t)l * KVL * NKVB, KVL, NKVB, (bf16*)(wb + WO_UKV), KVL, WK_UKV, (const float*)a->in[13] + l * KVL, 0};
    d[3] = WDesc{(const float*)a->in[17] + (size_t)l * DM * DM, DM, DM, (bf16*)(wb + WO_OUT), DM, WK_OUT, nullptr, 0};
    d[4] = WDesc{(const float*)a->in[18] + (size_t)l * DM * DFF, DM, DFF, (bf16*)(wb + WO_GU), DM, WK_GATE, nullptr, 0};
    d[5] = WDesc{(const float*)a->in[19] + (size_t)l * DM * DFF, DM, DFF, (bf16*)(wb + WO_GU), DM, WK_UP, nullptr, 0};
    d[6] = WDesc{(const float*)a->in[20] + (size_t)l * DFF * DM, DFF, DM, (bf16*)(wb + WO_DN), DFF, WK_DN, nullptr, 0};
#pragma unroll
    for (int i = 0; i < 7; ++i) d[i].nitems = (d[i].K / 64) * ((d[i].N + 31) / 32);
}
constexpr int WITEMS_EARLY = 32 * 133 + 7 * 24 + 2 * 32;
constexpr int WITEMS_LATE = 32 * 64 + 2 * 32 * 176 + 88 * 64;
__device__ __forceinline__ void convert_items(KArgs a, int l, int dlo, int dhi, int i0, int i1, int step, LAS float* scr, int lane) {
    WDesc d[7]; wdesc_layer(a, l, d);
    for (int it = i0; it < i1; it += step) {
        int r = it;
#pragma unroll
        for (int i = 0; i < 7; ++i) if (i >= dlo && i < dhi) { if (r >= 0 && r < d[i].nitems) transpose_item(d[i].W, d[i].K, d[i].N, d[i].WT, d[i].ldt, d[i].kind, d[i].rowg, scr, r, lane); r -= d[i].nitems; }
    }
}
constexpr int NDEF_ITEMS = WITEMS_LATE + WITEMS_EARLY + WITEMS_LATE, DEF_CHUNK = 64, NDEF_CHUNKS = (NDEF_ITEMS + DEF_CHUNK - 1) / DEF_CHUNK;
__device__ __forceinline__ void convert_deferred_chunk(KArgs a, LAS unsigned char* lds, int chunk, int wave, int lane) {
    LAS float* scr = (LAS float*)(lds + RING_OFF + wave * 16384);
    const int i0 = chunk * DEF_CHUNK, i1 = (i0 + DEF_CHUNK < NDEF_ITEMS) ? i0 + DEF_CHUNK : NDEF_ITEMS;
    { const int lo = i0, hi = i1 < WITEMS_LATE ? i1 : WITEMS_LATE; if (lo < hi) convert_items(a, 0, 3, 7, lo + wave, hi, NWAVES, scr, lane); }
    { const int lo = (i0 > WITEMS_LATE ? i0 : WITEMS_LATE) - WITEMS_LATE, hi = (i1 < WITEMS_LATE + WITEMS_EARLY ? i1 : WITEMS_LATE + WITEMS_EARLY) - WITEMS_LATE; if (lo < hi) convert_items(a, 1, 0, 3, lo + wave, hi, NWAVES, scr, lane); }
    { const int lo = (i0 > WITEMS_LATE + WITEMS_EARLY ? i0 : WITEMS_LATE + WITEMS_EARLY) - (WITEMS_LATE + WITEMS_EARLY), hi = i1 - (WITEMS_LATE + WITEMS_EARLY); if (lo < hi) convert_items(a, 1, 3, 7, lo + wave, hi, NWAVES, scr, lane); }
}

template <int PARTS> __device__ __forceinline__ void p0_prologue(KArgs a, LAS unsigned char* lds, int wave, int lane, int tid) {
    const int G = gridDim.x, gw = blockIdx.x * NWAVES + wave, NGW = G * NWAVES;
    LAS float* scr = (LAS float*)(lds + RING_OFF + wave * 16384);
    if (PARTS & 1) {
        convert_items(a, 0, 0, 7, gw, WITEMS_EARLY + WITEMS_LATE, NGW, scr, lane);
        convert_items(a, 1, 0, 7, gw, WITEMS_EARLY + WITEMS_LATE, NGW, scr, lane);
        for (int l = 0; l < DEPTH; ++l) { unsigned char* wb = a->ws + WS_W + (size_t)l * W_LAYER;
          bf16* wt = (bf16*)(wb + WO_IN); const int n16 = (NINP - 4256) * DM / 8;
          for (int i = blockIdx.x * NTHR + tid; i < n16; i += G * NTHR) *(GAS v4u*)(wt + (size_t)4256 * DM + (size_t)i * 8) = (v4u){0u, 0u, 0u, 0u};
          bf16* wq = (bf16*)(wb + WO_UQ); const int q16 = NQB * (QLP - QL) / 8;
          for (int i = blockIdx.x * NTHR + tid; i < q16; i += G * NTHR) { const int rr = i / ((QLP - QL) / 8), cc = i % ((QLP - QL) / 8); *(GAS v4u*)(wq + (size_t)rr * QLP + QL + cc * 8) = (v4u){0u, 0u, 0u, 0u}; } }
    }
    if (PARTS & 2) { const int* pos = (const int*)a->in[2]; float* cs = (float*)(a->ws + WS_COS); float* sn = (float*)(a->ws + WS_SIN);
      for (int i = blockIdx.x * NTHR + tid; i < M * 32; i += G * NTHR) { const int m = i >> 5, k = i & 31; const double ang = (double)pos[m] * INVF[k] * 0.15915494309189533577; const double r = ang - __builtin_floor(ang);
          float s, c; sincos_rev(r, s, c); cs[i] = c; sn[i] = s; } }
    __syncthreads();
    if (PARTS & 4) { LAS float* sc = (LAS float*)(lds + RING_OFF);
      LAS float* red = (LAS float*)(lds + RING_OFF + 65536);
      const float* cin = (const float*)a->in[1];
      for (int i = tid; i < BATCH * DM; i += NTHR) { const float x = cin[i]; sc[i] = x / (1.0f + __expf(-x)); }
      __syncthreads();
      const float* mw = (const float*)a->in[3]; const float* mb = (const float*)a->in[4]; float* mod = (float*)(a->ws + WS_MOD);
      for (int cg = blockIdx.x; cg < 256; cg += G) {
          const int l = cg / 128, n0 = (cg % 128) * 96;
          if (tid < 480) { const int c4 = tid % 24, ks = tid / 24; const float* wp = mw + (size_t)l * DM * NMOD + n0 + 4 * c4; f32x4 acc[8];
#pragma unroll
              for (int b = 0; b < 8; ++b) acc[b] = (f32x4){0.f, 0.f, 0.f, 0.f};
#pragma unroll 4
              for (int k = ks; k < DM; k += 20) { const f32x4 w = *(const GAS f32x4*)(wp + (size_t)k * NMOD);
#pragma unroll
                  for (int b = 0; b < 8; ++b) acc[b] += w * sc[b * DM + k]; }
#pragma unroll
              for (int b = 0; b < 8; ++b) *(LAS f32x4*)(red + (ks * 8 + b) * 96 + 4 * c4) = acc[b]; }
          __syncthreads();
          for (int i = tid; i < 768; i += NTHR) { const int b = i / 96, cc = i % 96; float s = 0.f;
#pragma unroll
              for (int ks = 0; ks < 20; ++ks) s += red[(ks * 8 + b) * 96 + cc];
              mod[((size_t)l * BATCH + b) * NMOD + n0 + cc] = s + mb[(size_t)l * NMOD + n0 + cc]; }
          __syncthreads();
      }
    }
}

__device__ __forceinline__ void prep_rows(KArgs a, int wave, int lane) {
    const bf16* proj = (const bf16*)(a->ws + WS_PROJ); float* rsq = (float*)(a->ws + WS_RSQ); float* rskv = (float*)(a->ws + WS_RSKV); bf16* kr = (bf16*)(a->ws + WS_KROPE);
    const float* cs = (const float*)(a->ws + WS_COS); const float* sn = (const float*)(a->ws + WS_SIN);
    const int gw = blockIdx.x * NWAVES + wave, NGW = gridDim.x * NWAVES;
    for (int m0 = gw * 4; m0 < M; m0 += NGW * 4) {
        v4u wq[4], wk[4]; unsigned short x1[4], x2[4]; float cc[4], ss[4];
#pragma unroll
        for (int j = 0; j < 4; ++j) { const bf16* p = proj + (size_t)(m0 + j) * NINP; wq[j] = (v4u){0u, 0u, 0u, 0u}; wk[j] = (v4u){0u, 0u, 0u, 0u};
            if (lane < 56) wq[j] = *(const GAS v4u*)(p + C_BCQ + lane * 8);
            if (lane < 16) wk[j] = *(const GAS v4u*)(p + C_BCKV + lane * 8);
            x1[j] = p[C_BKR + (lane & 31)]; x2[j] = p[C_BKR + 32 + (lane & 31)]; cc[j] = cs[(size_t)(m0 + j) * 32 + (lane & 31)]; ss[j] = sn[(size_t)(m0 + j) * 32 + (lane & 31)]; }
#pragma unroll
        for (int j = 0; j < 4; ++j) { float s1 = 0.f, s2 = 0.f;
#pragma unroll
            for (int e = 0; e < 4; ++e) { const float x = bflo(wq[j][e]), y = bfhi(wq[j][e]); s1 += x * x + y * y; const float u = bflo(wk[j][e]), v = bfhi(wk[j][e]); s2 += u * u + v * v; }
            s1 = wave_sum(s1); s2 = wave_sum(s2);
            if (lane == 0) { rsq[m0 + j] = 1.0f / sqrtf(s1 * (1.0f / QL) + EPS); rskv[m0 + j] = 1.0f / sqrtf(s2 * (1.0f / KVL) + EPS); }
            if (lane < 32) { const float a1 = bf2f(x1[j]), a2 = bf2f(x2[j]); *(GAS unsigned*)(kr + (size_t)(m0 + j) * 64 + 2 * lane) = pk2(a1 * cc[j] - a2 * ss[j], a1 * ss[j] + a2 * cc[j]); } }
    }
}

__device__ __forceinline__ void ld8(const bf16* p, float* o) { const v4u w = *(const GAS v4u*)p;
#pragma unroll
    for (int j = 0; j < 4; ++j) { o[2 * j] = bflo(w[j]); o[2 * j + 1] = bfhi(w[j]); } }

__device__ __forceinline__ void naive_window(KArgs a, int l, int tid) {
    const bf16* proj = (const bf16*)(a->ws + WS_PROJ); bf16* ycat = (bf16*)(a->ws + WS_YCAT); const float* sink = (const float*)a->in[10] + l * 12;
    const int gt = blockIdx.x * NTHR + tid, NT = gridDim.x * NTHR;
    for (int it = gt; it < M * 12; it += NT) {
        const int m = it / 12, hq = it % 12, b = m / SEQ, t = m % SEQ, kvh = hq / 3;
        float q[64], acc[64];
#pragma unroll
        for (int j = 0; j < 8; ++j) ld8(proj + (size_t)m * NINP + C_AQ + hq * 64 + 8 * j, q + 8 * j);
#pragma unroll
        for (int d = 0; d < 64; ++d) acc[d] = 0.f;
        float mr = sink[hq] * LOG2E, lr = 1.0f; const float slope = ALIBI[hq] * LOG2E;
        const int s0 = t - 128 < 0 ? 0 : t - 128, s1 = t + 128 > SEQ - 1 ? SEQ - 1 : t + 128;
        for (int s = s0; s <= s1; ++s) {
            const bf16* kp = proj + (size_t)(b * SEQ + s) * NINP + C_AK + kvh * 64; const bf16* vp = proj + (size_t)(b * SEQ + s) * NINP + C_AV + kvh * 64;
            float dot = 0.f;
#pragma unroll
            for (int j = 0; j < 8; ++j) { float k8[8]; ld8(kp + 8 * j, k8);
#pragma unroll
                for (int e = 0; e < 8; ++e) dot += q[8 * j + e] * k8[e]; }
            const int dist = t > s ? t - s : s - t; const float sc = dot - slope * (float)dist;
            const float mn = fmaxf(mr, sc), corr = __builtin_amdgcn_exp2f(mr - mn), p = __builtin_amdgcn_exp2f(sc - mn); lr = lr * corr + p; mr = mn;
#pragma unroll
            for (int j = 0; j < 8; ++j) { float v8[8]; ld8(vp + 8 * j, v8);
#pragma unroll
                for (int e = 0; e < 8; ++e) acc[8 * j + e] = acc[8 * j + e] * corr + p * v8[e]; }
        }
        const float inv = 1.0f / lr; bf16* op = ycat + (size_t)m * DM + hq * 64;
#pragma unroll
        for (int j = 0; j < 8; ++j) { v4u w; w.x = pk2(acc[8 * j] * inv, acc[8 * j + 1] * inv); w.y = pk2(acc[8 * j + 2] * inv, acc[8 * j + 3] * inv); w.z = pk2(acc[8 * j + 4] * inv, acc[8 * j + 5] * inv); w.w = pk2(acc[8 * j + 6] * inv, acc[8 * j + 7] * inv); *(GAS v4u*)(op + 8 * j) = w; }
    }
}
__device__ __forceinline__ void naive_mla(KArgs a, int tid) {
    const bf16* qm = (const bf16*)(a->ws + WS_QMLA); const bf16* kv = (const bf16*)(a->ws + WS_KVMLA); const bf16* kr = (const bf16*)(a->ws + WS_KROPE); bf16* ycat = (bf16*)(a->ws + WS_YCAT);
    const int gt = blockIdx.x * NTHR + tid, NT = gridDim.x * NTHR, g = gt & 3;
    for (int it = gt >> 2; it < M * 4; it += NT >> 2) {
        const int m = it >> 2, h = it & 3, b = m / SEQ;
        float q[48], acc[32];
#pragma unroll
        for (int j = 0; j < 4; ++j) ld8(qm + (size_t)m * NQB + h * 192 + 32 * g + 8 * j, q + 8 * j);
#pragma unroll
        for (int j = 0; j < 2; ++j) ld8(qm + (size_t)m * NQB + h * 192 + 128 + 16 * g + 8 * j, q + 32 + 8 * j);
#pragma unroll
        for (int d = 0; d < 32; ++d) acc[d] = 0.f;
        float mr = -INFINITY, lr = 0.f;
        for (int s = 0; s < SEQ; ++s) {
            const size_t row = (size_t)b * SEQ + s; const bf16* kp = kv + row * NKVB + h * 256 + 32 * g; const bf16* rp = kr + row * 64 + 16 * g; const bf16* vp = kv + row * NKVB + h * 256 + 128 + 32 * g;
            float dot = 0.f;
#pragma unroll
            for (int j = 0; j < 4; ++j) { float k8[8]; ld8(kp + 8 * j, k8);
#pragma unroll
                for (int e = 0; e < 8; ++e) dot += q[8 * j + e] * k8[e]; }
#pragma unroll
            for (int j = 0; j < 2; ++j) { float k8[8]; ld8(rp + 8 * j, k8);
#pragma unroll
                for (int e = 0; e < 8; ++e) dot += q[32 + 8 * j + e] * k8[e]; }
            dot += __shfl_xor(dot, 1); dot += __shfl_xor(dot, 2);
            const float mn = fmaxf(mr, dot), corr = __builtin_amdgcn_exp2f(mr - mn), p = __builtin_amdgcn_exp2f(dot - mn); lr = lr * corr + p; mr = mn;
#pragma unroll
            for (int j = 0; j < 4; ++j) { float v8[8]; ld8(vp + 8 * j, v8);
#pragma unroll
                for (int e = 0; e < 8; ++e) acc[8 * j + e] = acc[8 * j + e] * corr + p * v8[e]; }
        }
        const float inv = 1.0f / lr; bf16* op = ycat + (size_t)m * DM + 768 + h * 128 + 32 * g;
#pragma unroll
        for (int j = 0; j < 4; ++j) { v4u w; w.x = pk2(acc[8 * j] * inv, acc[8 * j + 1] * inv); w.y = pk2(acc[8 * j + 2] * inv, acc[8 * j + 3] * inv); w.z = pk2(acc[8 * j + 4] * inv, acc[8 * j + 5] * inv); w.w = pk2(acc[8 * j + 6] * inv, acc[8 * j + 7] * inv); *(GAS v4u*)(op + 8 * j) = w; }
    }
}
__device__ __forceinline__ void naive_mlstm(KArgs a, int l, LAS unsigned char* lds, int tid) {
    const bf16* proj = (const bf16*)(a->ws + WS_PROJ); float* hf = (float*)a->out; const float* gb = (const float*)a->in[15] + l * 16;
    LAS float* den_s = (LAS float*)(lds + RING_OFF); LAS float* mt_s = den_s + SEQ;
    for (int job = blockIdx.x; job < 64; job += gridDim.x) {
        const int dir = job & 1, bh = job >> 1, b = bh >> 2, h = bh & 3; const int e = tid;
        float* hd = hf + (size_t)dir * M * 768;
        if (e <= 192) {
            float C[96];
#pragma unroll
            for (int d = 0; d < 96; ++d) C[d] = 0.f;
            float mrun = -INFINITY;
            const float bi = gb[(dir ? 1 : 0) * 4 + h], bfg = gb[(dir ? 3 : 2) * 4 + h];
            for (int tt = 0; tt < SEQ; ++tt) {
                const int t = dir ? SEQ - 1 - tt : tt; const bf16* p = proj + (size_t)(b * SEQ + t) * NINP;
                const float li = bf2f(p[C_CG + (dir ? 1 : 0) * 4 + h]) + bi, fp = bf2f(p[C_CG + (dir ? 3 : 2) * 4 + h]) + bfg;
                const float lf = fminf(fp, 0.f) - log1pf(__expf(-fabsf(fp)));
                const float mn = fmaxf(lf + mrun, li), fa = __expf(lf + mrun - mn), fb = __expf(li - mn); mrun = mn;
                const float v = (e < 192) ? bf2f(p[C_CV + h * 192 + e]) : 1.0f; const float bv = fb * v;
                float num = 0.f;
#pragma unroll
                for (int j = 0; j < 12; ++j) { float q8[8], k8[8]; ld8(p + C_CQ + h * 96 + 8 * j, q8); ld8(p + C_CK + h * 96 + 8 * j, k8);
#pragma unroll
                    for (int d = 0; d < 8; ++d) { C[8 * j + d] = fa * C[8 * j + d] + bv * k8[d]; num += q8[d] * C[8 * j + d]; } }
                if (e < 192) hd[(size_t)(b * SEQ + t) * 768 + h * 192 + e] = num; else { den_s[t] = num; mt_s[t] = mn; }
            }
        }
        __syncthreads();
        if (e < 192) { for (int t = 0; t < SEQ; ++t) { float* q = hd + (size_t)(b * SEQ + t) * 768 + h * 192 + e; *q = *q / fmaxf(fabsf(den_s[t]), __expf(-mt_s[t])); } }
        __syncthreads();
    }
}
__device__ __forceinline__ void mlstm_combine(KArgs a, int l, int wave, int lane) {
    const bf16* proj = (const bf16*)(a->ws + WS_PROJ); const float* hf = (const float*)a->out; const float* hb = hf + (size_t)M * 768; bf16* ycat = (bf16*)(a->ws + WS_YCAT);
    const float* hg = (const float*)a->in[16] + l * 768; const float* dnp = (const float*)(a->ws + WS_GPREP);
    const int gw = blockIdx.x * NWAVES + wave, NGW = gridDim.x * NWAVES;
    float g[12];
#pragma unroll
    for (int i = 0; i < 12; ++i) g[i] = hg[64 * i + lane];
    for (int m0 = gw * 2; m0 < M; m0 += NGW * 2) {
        float xf[2][12], xb[2][12], op[2][12]; f32x4 df[2], db[2];
#pragma unroll
        for (int j = 0; j < 2; ++j) { const size_t m = (size_t)(m0 + j);
            df[j] = *(const GAS f32x4*)(dnp + m * 4); db[j] = *(const GAS f32x4*)(dnp + ((size_t)M + m) * 4);
#pragma unroll
            for (int i = 0; i < 12; ++i) { xf[j][i] = hf[m * 768 + 64 * i + lane]; xb[j][i] = hb[m * 768 + 64 * i + lane]; op[j][i] = bf2f(proj[m * NINP + C_CO + 64 * i + lane]); } }
#pragma unroll
        for (int j = 0; j < 2; ++j) { const size_t m = (size_t)(m0 + j);
#pragma unroll
            for (int h = 0; h < 4; ++h) { const float d0 = 1.0f / df[j][h], d1 = 1.0f / db[j][h]; float x[3]; float ss = 0.f;
#pragma unroll
                for (int i = 0; i < 3; ++i) { x[i] = xf[j][3 * h + i] * d0 + xb[j][3 * h + i] * d1; ss += x[i] * x[i]; }
                const float rstd = 1.0f / sqrtf(wave_sum(ss) * (1.0f / 192) + EPS);
#pragma unroll
                for (int i = 0; i < 3; ++i) { const int c = h * 192 + 64 * i + lane; const float sg = 1.0f / (1.0f + __expf(-op[j][3 * h + i]));
                    ycat[m * DM + 1280 + c] = (bf16)f2bf(sg * x[i] * rstd * g[3 * h + i]); } } }
    }
}

typedef float f32x16 __attribute__((ext_vector_type(16)));
typedef short v4i16_t __attribute__((ext_vector_type(4)));
typedef float f32x2_t __attribute__((ext_vector_type(2))); typedef __bf16 bf16x2_t __attribute__((ext_vector_type(2)));
__device__ __forceinline__ unsigned cvtpk(float lo, float hi) { f32x2_t v = {lo, hi}; bf16x2_t b = __builtin_convertvector(v, bf16x2_t); return __builtin_bit_cast(unsigned, b); }
__device__ __forceinline__ v4i16_t vtr(LAS unsigned char* p) { return __builtin_amdgcn_ds_read_tr16_b64_v4i16((LAS v4i16_t*)p); }
__device__ __forceinline__ bf16x8 mk8(v4i16_t lo, v4i16_t hi) { return (bf16x8){lo[0], lo[1], lo[2], lo[3], hi[0], hi[1], hi[2], hi[3]}; }
__device__ __forceinline__ bf16x8 pack8(const f32x16& p, int s) {
    v4u w; w.x = cvtpk(p[8 * s + 0], p[8 * s + 1]); w.y = cvtpk(p[8 * s + 2], p[8 * s + 3]); w.z = cvtpk(p[8 * s + 4], p[8 * s + 5]); w.w = cvtpk(p[8 * s + 6], p[8 * s + 7]);
    return __builtin_bit_cast(bf16x8, w);
}
__device__ __forceinline__ float max16(const f32x16& p) {
    float a = fmaxf(fmaxf(p[0], p[1]), fmaxf(p[2], p[3])), b = fmaxf(fmaxf(p[4], p[5]), fmaxf(p[6], p[7])), c = fmaxf(fmaxf(p[8], p[9]), fmaxf(p[10], p[11])), d = fmaxf(fmaxf(p[12], p[13]), fmaxf(p[14], p[15]));
    return fmaxf(fmaxf(a, b), fmaxf(c, d));
}
__device__ __forceinline__ float sum16(const f32x16& p) {
    return (((p[0] + p[1]) + (p[2] + p[3])) + ((p[4] + p[5]) + (p[6] + p[7]))) + (((p[8] + p[9]) + (p[10] + p[11])) + ((p[12] + p[13]) + (p[14] + p[15])));
}

constexpr int MLA_KN = 0, MLA_KR = 16384, MLA_V = 24576, MLA_BUF = 40960;
static_assert(2 * MLA_BUF <= RING_BYTES, "MLA LDS");
__device__ __forceinline__ void mla_dma(const bf16* kvb  , const bf16* krb  , LAS unsigned char* buf, int wave, unsigned okn0, unsigned okn1, unsigned okr, unsigned ov0, unsigned ov1) {
    const GAS char* kb = (const GAS char*)kvb; const GAS char* rb = (const GAS char*)krb;
    __builtin_amdgcn_global_load_lds((const GAS unsigned*)(kb + okn0), (LAS unsigned*)(buf + MLA_KN + wave * 2048), 16, 0, 0);
    __builtin_amdgcn_global_load_lds((const GAS unsigned*)(kb + okn1), (LAS unsigned*)(buf + MLA_KN + wave * 2048 + 1024), 16, 0, 0);
    __builtin_amdgcn_global_load_lds((const GAS unsigned*)(rb + okr), (LAS unsigned*)(buf + MLA_KR + wave * 1024), 16, 0, 0);
    __builtin_amdgcn_global_load_lds((const GAS unsigned*)(kb + ov0), (LAS unsigned*)(buf + MLA_V + wave * 2048), 16, 0, 0);
    __builtin_amdgcn_global_load_lds((const GAS unsigned*)(kb + ov1), (LAS unsigned*)(buf + MLA_V + wave * 2048 + 1024), 16, 0, 0);
}
__device__ __forceinline__ void mla_unit(const bf16* qm, const bf16* kv, const bf16* kr, bf16* ycat, LAS unsigned char* lds, int b, int h, int qb, int wave, int ln) {
    const int r = ln & 31, hh = ln >> 5;
    const size_t row0 = (size_t)b * SEQ; const int q0 = qb * 256 + wave * 32;
    unsigned okn0, okn1, okr, ov0, ov1;
    { const int rA = 8 * wave + (ln >> 4), rB = rA + 4, pc = ln & 15;
      okn0 = (unsigned)(rA * NKVB * 2 + ((pc ^ (rA & 15)) * 16)); okn1 = (unsigned)(rB * NKVB * 2 + ((pc ^ (rB & 15)) * 16));
      const int rr = 8 * wave + (ln >> 3), pr = ln & 7; okr = (unsigned)(rr * 128 + ((pr ^ ((rr >> 1) & 7)) * 16));
      ov0 = (unsigned)(rA * NKVB * 2 + 256 + (((((pc >> 2) ^ (rA & 3)) << 2) | (pc & 3)) * 16)); ov1 = (unsigned)(rB * NKVB * 2 + 256 + (((((pc >> 2) ^ (rB & 3)) << 2) | (pc & 3)) * 16)); }
    const bf16* kvb = kv + row0 * NKVB + h * 256; const bf16* krb = kr + row0 * 64;
    mla_dma(kvb, krb, lds, wave, okn0, okn1, okr, ov0, ov1);
    bf16x8 qf[12];
    { const bf16* qp = qm + (row0 + q0 + r) * NQB + h * 192 + 8 * hh;
#pragma unroll
      for (int d0 = 0; d0 < 12; ++d0) qf[d0] = *(const GAS bf16x8*)(qp + 16 * d0); }
    f32x16 o[4];
#pragma unroll
    for (int db = 0; db < 4; ++db)
#pragma unroll
        for (int i = 0; i < 16; ++i) o[db][i] = 0.f;
    float mrun = 0.f, lrun = 0.f;
    const int q4 = (ln & 15) >> 2;
    const int kn_base = MLA_KN + r * 256 + (((r & 15) ^ hh) * 16), kr_base = MLA_KR + r * 128 + ((((r >> 1) & 7) ^ hh) * 16);
    const int v_base = MLA_V + (4 * hh + q4) * 256 + q4 * 64 + (((ln >> 4) & 1) * 16 + (ln & 3) * 4) * 2;
    for (int kt = 0; kt < SEQ / 64; ++kt) {
        __syncthreads();
        LAS unsigned char* buf = lds + (kt & 1) * MLA_BUF;
        if (kt + 1 < SEQ / 64) mla_dma(kvb + (size_t)(kt + 1) * 64 * NKVB, krb + (size_t)(kt + 1) * 64 * 64, lds + ((kt + 1) & 1) * MLA_BUF, wave, okn0, okn1, okr, ov0, ov1);
        f32x16 s0, s1;
        { const float negm = -mrun;
#pragma unroll
          for (int i = 0; i < 16; ++i) { s0[i] = negm; s1[i] = negm; } }
        {
            bf16x8 ka[2][2];
#define MLA_KLD(dst, d0_) do { if ((d0_) < 8) { LAS unsigned char* kp_ = buf + (kn_base ^ ((d0_) * 32)); dst[0] = *(LAS bf16x8*)kp_; dst[1] = *(LAS bf16x8*)(kp_ + 32 * 256); } \
                               else { LAS unsigned char* kp_ = buf + (kr_base ^ (((d0_) - 8) * 32)); dst[0] = *(LAS bf16x8*)kp_; dst[1] = *(LAS bf16x8*)(kp_ + 32 * 128); } } while (0)
            MLA_KLD(ka[0], 0);
#pragma unroll
            for (int d0 = 0; d0 < 12; ++d0) {
                if (d0 + 1 < 12) MLA_KLD(ka[(d0 + 1) & 1], d0 + 1);
                s0 = __builtin_amdgcn_mfma_f32_32x32x16_bf16(ka[d0 & 1][0], qf[d0], s0, 0, 0, 0); s1 = __builtin_amdgcn_mfma_f32_32x32x16_bf16(ka[d0 & 1][1], qf[d0], s1, 0, 0, 0);
            }
#undef MLA_KLD
        }
        float mx = fmaxf(max16(s0), max16(s1)); mx = fmaxf(mx, __shfl_xor(mx, 32));
        if (__builtin_expect(__any(mx > 6.0f) || kt == 0, 0)) {
            const float delta = (kt == 0) ? mx : fmaxf(mx, 0.f), alpha = __builtin_amdgcn_exp2f(-delta); mrun += delta; lrun *= alpha;
#pragma unroll
            for (int i = 0; i < 16; ++i) { s0[i] -= delta; s1[i] -= delta; }
#pragma unroll
            for (int db = 0; db < 4; ++db)
#pragma unroll
                for (int i = 0; i < 16; ++i) o[db][i] *= alpha;
        }
#pragma unroll
        for (int i = 0; i < 16; ++i) { s0[i] = __builtin_amdgcn_exp2f(s0[i]); s1[i] = __builtin_amdgcn_exp2f(s1[i]); }
        lrun += sum16(s0) + sum16(s1);
        const bf16x8 p00 = pack8(s0, 0), p01 = pack8(s0, 1), p10 = pack8(s1, 0), p11 = pack8(s1, 1);
        {
            bf16x8 va[2][4];
#define MLA_VLD(dst, db_) do { LAS unsigned char* vb_ = buf + (v_base ^ ((db_) * 64)); dst[0] = mk8(vtr(vb_), vtr(vb_ + 8 * 256)); dst[1] = mk8(vtr(vb_ + 16 * 256), vtr(vb_ + 24 * 256)); \
                               dst[2] = mk8(vtr(vb_ + 32 * 256), vtr(vb_ + 40 * 256)); dst[3] = mk8(vtr(vb_ + 48 * 256), vtr(vb_ + 56 * 256)); } while (0)
            MLA_VLD(va[0], 0);
#pragma unroll
            for (int db = 0; db < 4; ++db) {
                if (db + 1 < 4) MLA_VLD(va[(db + 1) & 1], db + 1);
                o[db] = __builtin_amdgcn_mfma_f32_32x32x16_bf16(va[db & 1][0], p00, o[db], 0, 0, 0); o[db] = __builtin_amdgcn_mfma_f32_32x32x16_bf16(va[db & 1][1], p01, o[db], 0, 0, 0);
                o[db] = __builtin_amdgcn_mfma_f32_32x32x16_bf16(va[db & 1][2], p10, o[db], 0, 0, 0); o[db] = __builtin_amdgcn_mfma_f32_32x32x16_bf16(va[db & 1][3], p11, o[db], 0, 0, 0);
            }
#undef MLA_VLD
        }
    }
    lrun += __shfl_xor(lrun, 32);
    const float inv = 1.0f / lrun;
    bf16* op = ycat + (row0 + q0 + r) * DM + 768 + h * 128 + 4 * hh;
#pragma unroll
    for (int db = 0; db < 4; ++db)
#pragma unroll
        for (int g4 = 0; g4 < 4; ++g4) { v2u w; w.x = cvtpk(o[db][4 * g4] * inv, o[db][4 * g4 + 1] * inv); w.y = cvtpk(o[db][4 * g4 + 2] * inv, o[db][4 * g4 + 3] * inv); *(GAS v2u*)(op + 32 * db + 8 * g4) = w; }
}
__device__ __forceinline__ void mla_phase(KArgs a, LAS unsigned char* lds, int wave, int ln) {
    const bf16* qm = (const bf16*)(a->ws + WS_QMLA); const bf16* kv = (const bf16*)(a->ws + WS_KVMLA); const bf16* kr = (const bf16*)(a->ws + WS_KROPE); bf16* ycat = (bf16*)(a->ws + WS_YCAT);
    const int G = gridDim.x;
    const int xcd = blockIdx.x & 7, slot = blockIdx.x >> 3, per = (G + 7) >> 3;
    for (int v = slot; v < 64; v += per) { const int bh = xcd * 4 + (v >> 4), qb = v & 15; mla_unit(qm, kv, kr, ycat, lds, bh >> 2, bh & 3, qb, wave, ln); }
}

constexpr int WIN_VP = 192;
static_assert(512 * WIN_VP <= RING_BYTES, "window LDS");
__device__ __forceinline__ void win_unit(const bf16* proj, bf16* ycat, float sinkv, float slope, LAS unsigned char* lds, int b, int hq, int qb, int wave, int ln) {
    const int r = ln & 31, hh = ln >> 5, t = wave * 64 + ln, kvh = hq / 3;
    const size_t row0 = (size_t)b * SEQ; const int q0 = qb * 256, ks0 = q0 - 128;
    __syncthreads();
#pragma unroll
    for (int c = 0; c < 8; ++c) { const int idx = t + 512 * c, key = idx >> 3, ch = idx & 7; int s = ks0 + key; s = s < 0 ? 0 : (s > SEQ - 1 ? SEQ - 1 : s);
        const v4u w = *(const GAS v4u*)(proj + (row0 + s) * NINP + C_AV + kvh * 64 + ch * 8); *(LAS v4u*)(lds + key * WIN_VP + ch * 16) = w; }
    const int tq = q0 + wave * 32 + r;
    bf16x8 qf[4];
    { const bf16* qp = proj + (row0 + tq) * NINP + C_AQ + hq * 64 + 8 * hh;
#pragma unroll
      for (int d0 = 0; d0 < 4; ++d0) qf[d0] = *(const GAS bf16x8*)(qp + 16 * d0); }
    f32x16 o[2];
#pragma unroll
    for (int db = 0; db < 2; ++db)
#pragma unroll
        for (int i = 0; i < 16; ++i) o[db][i] = 0.f;
    float mrun = sinkv, lrun = (hh == 0) ? 1.0f : 0.0f;
    const int kb0 = q0 + wave * 32 - 128;
    const int voff = (wave * 32 + 4 * hh + ((ln & 15) >> 2)) * WIN_VP + (((ln >> 4) & 1) * 16 + (ln & 3) * 4) * 2;
    bf16x8 kf[4], kn[4];
    { int s = kb0 + r; s = s < 0 ? 0 : (s > SEQ - 1 ? SEQ - 1 : s); const bf16* kp = proj + (row0 + s) * NINP + C_AK + kvh * 64 + 8 * hh;
#pragma unroll
      for (int d0 = 0; d0 < 4; ++d0) kf[d0] = *(const GAS bf16x8*)(kp + 16 * d0); }
    __syncthreads();
#pragma unroll 1
    for (int kb = 0; kb < 9; ++kb) {
        const int kbase = kb0 + 32 * kb;
        if (kb < 8) { int s = kbase + 32 + r; s = s < 0 ? 0 : (s > SEQ - 1 ? SEQ - 1 : s); const bf16* kp = proj + (row0 + s) * NINP + C_AK + kvh * 64 + 8 * hh;
#pragma unroll
            for (int d0 = 0; d0 < 4; ++d0) kn[d0] = *(const GAS bf16x8*)(kp + 16 * d0); }
        f32x16 s0;
#pragma unroll
        for (int i = 0; i < 16; ++i) s0[i] = 0.f;
#pragma unroll
        for (int d0 = 0; d0 < 4; ++d0) s0 = __builtin_amdgcn_mfma_f32_32x32x16_bf16(kf[d0], qf[d0], s0, 0, 0, 0);
#pragma unroll
        for (int i = 0; i < 16; ++i) { const int key = kbase + (i & 3) + 8 * (i >> 2) + 4 * hh; const int dist = tq > key ? tq - key : key - tq;
            const bool ok = (key >= 0) && (key < SEQ) && (dist <= 128); s0[i] = ok ? s0[i] - slope * (float)dist : -INFINITY; }
        float mx = max16(s0); mx = fmaxf(mx, __shfl_xor(mx, 32));
        const float mnew = fmaxf(mrun, mx), alpha = __builtin_amdgcn_exp2f(mrun - mnew); mrun = mnew;
#pragma unroll
        for (int i = 0; i < 16; ++i) s0[i] = __builtin_amdgcn_exp2f(s0[i] - mnew);
        lrun = lrun * alpha + sum16(s0);
#pragma unroll
        for (int db = 0; db < 2; ++db)
#pragma unroll
            for (int i = 0; i < 16; ++i) o[db][i] *= alpha;
        const bf16x8 p0 = pack8(s0, 0), p1 = pack8(s0, 1);
#pragma unroll
        for (int db = 0; db < 2; ++db) { LAS unsigned char* vb = lds + voff + kb * 32 * WIN_VP + db * 64;
            const bf16x8 v0 = mk8(vtr(vb), vtr(vb + 8 * WIN_VP)), v1 = mk8(vtr(vb + 16 * WIN_VP), vtr(vb + 24 * WIN_VP));
            o[db] = __builtin_amdgcn_mfma_f32_32x32x16_bf16(v0, p0, o[db], 0, 0, 0); o[db] = __builtin_amdgcn_mfma_f32_32x32x16_bf16(v1, p1, o[db], 0, 0, 0); }
#pragma unroll
        for (int d0 = 0; d0 < 4; ++d0) kf[d0] = kn[d0];
    }
    lrun += __shfl_xor(lrun, 32);
    const float inv = 1.0f / lrun;
    bf16* op = ycat + (row0 + tq) * DM + hq * 64 + 4 * hh;
#pragma unroll
    for (int db = 0; db < 2; ++db)
#pragma unroll
        for (int g4 = 0; g4 < 4; ++g4) { v2u w; w.x = cvtpk(o[db][4 * g4] * inv, o[db][4 * g4 + 1] * inv); w.y = cvtpk(o[db][4 * g4 + 2] * inv, o[db][4 * g4 + 3] * inv); *(GAS v2u*)(op + 32 * db + 8 * g4) = w; }
}
__device__ __forceinline__ void win_phase(KArgs a, int l, LAS unsigned char* lds, int wave, int ln) {
    const bf16* proj = (const bf16*)(a->ws + WS_PROJ); bf16* ycat = (bf16*)(a->ws + WS_YCAT); const float* sink = (const float*)a->in[10] + l * 12;
    for (int u = blockIdx.x; u < BATCH * 12 * 16; u += gridDim.x) { const int qb = u & 15, hq = (u >> 4) % 12, b = u / 192;
        win_unit(proj, ycat, sink[hq] * LOG2E, ALIBI[hq] * LOG2E, lds, b, hq, qb, wave, ln); }
    __syncthreads();
}

constexpr int ML_U = 0, ML_MM = 16384, ML_BB = 32768, ML_MP = 49152, ML_IW = 49408, ML_T = 49664;
constexpr int ML_QP = 208, ML_KWP = 192, ML_VP = 448, ML_DP = 144;
constexpr int ML_Q = ML_T, ML_K = ML_Q + 64 * ML_QP, ML_KW = ML_K + 64 * ML_QP, ML_V = ML_KW + 64 * ML_KWP, ML_D = ML_V + 64 * ML_VP, ML_END = ML_D + 64 * ML_DP;
static_assert(ML_END <= RING_BYTES, "mLSTM LDS");
constexpr size_t WS_DN = WS_GPREP;
#define ML_BAR() asm volatile("s_waitcnt lgkmcnt(0)\n\ts_barrier" ::: "memory")
struct MlStage { v4u qk[3]; v4u v[3]; };
__device__ __forceinline__ void ml_load(MlStage& st, const bf16* base  , int h, int dir, int t) {
    const GAS char* bp = (const GAS char*)base;
#pragma unroll
    for (int k = 0; k < 3; ++k) { const int idx = t + 512 * k, which = idx / 768, rem = idx % 768, row = rem / 12, ch = rem % 12; const int pr = dir ? 63 - row : row;
        const unsigned off = (unsigned)(pr * NINP + (which ? C_CK : C_CQ) + h * 96 + ch * 8) * 2u; st.qk[k] = *(const GAS v4u*)(bp + off); }
#pragma unroll
    for (int k = 0; k < 3; ++k) { const int idx = t + 512 * k, row = idx / 24, ch = idx % 24; const int pr = dir ? 63 - row : row;
        const unsigned off = (unsigned)(pr * NINP + C_CV + h * 192 + ch * 8) * 2u; st.v[k] = *(const GAS v4u*)(bp + off); }
}
__device__ __forceinline__ void ml_store(const MlStage& st, LAS unsigned char* lds, int c, int t) {
    const float mlast = *(LAS float*)(lds + ML_MM + (c * 64 + 63) * 4);
#pragma unroll
    for (int k = 0; k < 3; ++k) { const int idx = t + 512 * k, which = idx / 768, rem = idx % 768, row = rem / 12, ch = rem % 12;
        if (which == 0) *(LAS v4u*)(lds + ML_Q + row * ML_QP + ch * 16) = st.qk[k];
        else { *(LAS v4u*)(lds + ML_K + row * ML_QP + ch * 16) = st.qk[k];
            const float sc = __expf(*(LAS float*)(lds + ML_U + (c * 64 + row) * 4) - mlast); v4u w;
#pragma unroll
            for (int j = 0; j < 4; ++j) w[j] = cvtpk(bflo(st.qk[k][j]) * sc, bfhi(st.qk[k][j]) * sc);
            *(LAS v4u*)(lds + ML_KW + row * ML_KWP + ch * 16) = w; } }
#pragma unroll
    for (int k = 0; k < 3; ++k) { const int idx = t + 512 * k, row = idx / 24, ch = idx % 24; *(LAS v4u*)(lds + ML_V + row * ML_VP + ch * 16) = st.v[k]; }
}
__device__ __forceinline__ void mlstm_job(KArgs a, int l, LAS unsigned char* lds, int job, int wave, int ln) {
    const bf16* proj = (const bf16*)(a->ws + WS_PROJ); float* hf = a->out; float* dn = (float*)(a->ws + WS_DN); const float* gb = (const float*)a->in[15] + l * 16;
    const int dir = job & 1, bh = job >> 1, b = bh >> 2, h = bh & 3, t = wave * 64 + ln, r = ln & 31, hh = ln >> 5;
    LAS float* U = (LAS float*)(lds + ML_U); LAS float* MM = (LAS float*)(lds + ML_MM); LAS float* BB = (LAS float*)(lds + ML_BB); LAS float* MP = (LAS float*)(lds + ML_MP); LAS float* IW = (LAS float*)(lds + ML_IW);
    __syncthreads();
    { const float bi = gb[(dir ? 1 : 0) * 4 + h], bfg = gb[(dir ? 3 : 2) * 4 + h];
      for (int k = 0; k < 8; ++k) { const int tp = t + 512 * k, tph = dir ? SEQ - 1 - tp : tp; const bf16* p = proj + (size_t)(b * SEQ + tph) * NINP + C_CG;
          const float li = bf2f(p[(dir ? 1 : 0) * 4 + h]) + bi, fp = bf2f(p[(dir ? 3 : 2) * 4 + h]) + bfg; U[tp] = li; BB[tp] = fminf(fp, 0.f) - log1pf(__expf(-fabsf(fp))); } }
    __syncthreads();
    if (wave == 0) {
        float bsum = 0.f, pm = -INFINITY;
        for (int i = 0; i < 64; ++i) { const int idx = ln * 64 + i; bsum += BB[idx]; const float u = U[idx] - bsum; pm = fmaxf(pm, u); BB[idx] = bsum; U[idx] = u; MM[idx] = pm; }
        float mp = -INFINITY;
        for (int c = 0; c < 64; ++c) { if (ln == c) MP[c] = mp; const float bl = __shfl(bsum, c), pl = __shfl(pm, c); mp = bl + fmaxf(mp, pl); }
    }
    __syncthreads();
    for (int k = 0; k < 8; ++k) { const int tp = t + 512 * k; MM[tp] = fmaxf(MP[tp >> 6], MM[tp]); }
    __syncthreads();
    MlStage st;
    const bf16* rowbase = proj + (size_t)(b * SEQ) * NINP;
    ml_load(st, rowbase + (size_t)(dir ? SEQ - 64 : 0) * NINP, h, dir, t); ml_store(st, lds, 0, t);
    f32x16 Cacc[3];
#pragma unroll
    for (int kb = 0; kb < 3; ++kb)
#pragma unroll
        for (int i = 0; i < 16; ++i) Cacc[kb][i] = 0.f;
    const bool is_den = (wave == 6);
    const int trow = (4 * hh + ((ln & 15) >> 2)), tcol = (((ln >> 4) & 1) * 16 + (ln & 3) * 4) * 2;
    const bf16x8 ones = (bf16x8){0x3F80, 0x3F80, 0x3F80, 0x3F80, 0x3F80, 0x3F80, 0x3F80, 0x3F80};
    __syncthreads();
    for (int c = 0; c < 64; ++c) {
        if (c + 1 < 64) ml_load(st, rowbase + (size_t)(dir ? SEQ - 64 - (c + 1) * 64 : (c + 1) * 64) * NINP, h, dir, t);
        const float mprev = MP[c], mlast = MM[c * 64 + 63];
        if (wave < 4) {
            const int sblk = wave >> 1, lblk = wave & 1;
            LAS unsigned char* dp = lds + ML_D + (32 * lblk + r) * ML_DP + (sblk * 4 + hh) * 16;
            if (sblk > lblk) { *(LAS v4u*)dp = (v4u){0u, 0u, 0u, 0u}; *(LAS v4u*)(dp + 32) = (v4u){0u, 0u, 0u, 0u}; }
            else {
                bf16x8 kf[6], qf[6];
#pragma unroll
                for (int d0 = 0; d0 < 6; ++d0) { kf[d0] = *(LAS bf16x8*)(lds + ML_K + (32 * sblk + r) * ML_QP + d0 * 32 + hh * 16); qf[d0] = *(LAS bf16x8*)(lds + ML_Q + (32 * lblk + r) * ML_QP + d0 * 32 + hh * 16); }
                const int lq = 32 * lblk + r; const float Ml = MM[c * 64 + lq];
                f32x4 us[4];
#pragma unroll
                for (int i4 = 0; i4 < 4; ++i4) us[i4] = *(LAS f32x4*)(lds + ML_U + (c * 64 + 32 * sblk + 8 * i4 + 4 * hh) * 4);
                f32x16 g;
#pragma unroll
                for (int i = 0; i < 16; ++i) g[i] = 0.f;
#pragma unroll
                for (int d0 = 0; d0 < 6; ++d0) g = __builtin_amdgcn_mfma_f32_32x32x16_bf16(kf[d0], qf[d0], g, 0, 0, 0);
#pragma unroll
                for (int i4 = 0; i4 < 4; ++i4) { const int s0 = 32 * sblk + 8 * i4 + 4 * hh;
#pragma unroll
                    for (int j = 0; j < 4; ++j) { const float e = __expf(us[i4][j] - Ml); g[4 * i4 + j] = (s0 + j <= lq) ? g[4 * i4 + j] * e : 0.f; } }
                *(LAS bf16x8*)dp = pack8(g, 0); *(LAS bf16x8*)(dp + 32) = pack8(g, 1);
            }
        } else if (wave == 4) { IW[ln] = __expf(mprev - MM[c * 64 + ln]); }
        ML_BAR();
        if (wave < 7) {
            bf16x8 vf[4];
            if (is_den) { vf[0] = ones; vf[1] = ones; vf[2] = ones; vf[3] = ones; }
            else {
#pragma unroll
                for (int ks = 0; ks < 4; ++ks) { LAS unsigned char* vb = lds + ML_V + (16 * ks + trow) * ML_VP + wave * 64 + tcol; vf[ks] = mk8(vtr(vb), vtr(vb + 8 * ML_VP)); } }
            bf16x8 qa[2][6], df[2][4]; f32x4 iw[2][4];
#pragma unroll
            for (int lblk = 0; lblk < 2; ++lblk) { LAS unsigned char* qrow = lds + ML_Q + (32 * lblk + r) * ML_QP + 8 * hh;
#pragma unroll
                for (int ks = 0; ks < 6; ++ks) { const v2u q0 = *(LAS v2u*)(qrow + ks * 32), q1 = *(LAS v2u*)(qrow + ks * 32 + 16); qa[lblk][ks] = __builtin_bit_cast(bf16x8, (v4u){q0.x, q0.y, q1.x, q1.y}); }
#pragma unroll
                for (int ks = 0; ks < 4; ++ks) df[lblk][ks] = *(LAS bf16x8*)(lds + ML_D + (32 * lblk + r) * ML_DP + (2 * ks + hh) * 16);
#pragma unroll
                for (int i4 = 0; i4 < 4; ++i4) iw[lblk][i4] = *(LAS f32x4*)(lds + ML_IW + (32 * lblk + 8 * i4 + 4 * hh) * 4); }
            bf16x8 cb[6];
#pragma unroll
            for (int kb = 0; kb < 3; ++kb) { cb[2 * kb] = pack8(Cacc[kb], 0); cb[2 * kb + 1] = pack8(Cacc[kb], 1); }
            f32x16 y0, y1;
#pragma unroll
            for (int i = 0; i < 16; ++i) { y0[i] = 0.f; y1[i] = 0.f; }
#pragma unroll
            for (int ks = 0; ks < 6; ++ks) { y0 = __builtin_amdgcn_mfma_f32_32x32x16_bf16(qa[0][ks], cb[ks], y0, 0, 0, 0); y1 = __builtin_amdgcn_mfma_f32_32x32x16_bf16(qa[1][ks], cb[ks], y1, 0, 0, 0); }
            bf16x8 kwf[3][4];
#pragma unroll
            for (int kb = 0; kb < 3; ++kb)
#pragma unroll
                for (int ks = 0; ks < 4; ++ks) { LAS unsigned char* kb_ = lds + ML_KW + (16 * ks + trow) * ML_KWP + kb * 64 + tcol; kwf[kb][ks] = mk8(vtr(kb_), vtr(kb_ + 8 * ML_KWP)); }
#pragma unroll
            for (int i4 = 0; i4 < 4; ++i4)
#pragma unroll
                for (int j = 0; j < 4; ++j) { y0[4 * i4 + j] *= iw[0][i4][j]; y1[4 * i4 + j] *= iw[1][i4][j]; }
#pragma unroll
            for (int ks = 0; ks < 4; ++ks) { y0 = __builtin_amdgcn_mfma_f32_32x32x16_bf16(df[0][ks], vf[ks], y0, 0, 0, 0); y1 = __builtin_amdgcn_mfma_f32_32x32x16_bf16(df[1][ks], vf[ks], y1, 0, 0, 0); }
            const float sp = __expf(mprev - mlast);
#pragma unroll
            for (int kb = 0; kb < 3; ++kb)
#pragma unroll
                for (int i = 0; i < 16; ++i) Cacc[kb][i] *= sp;
#pragma unroll
            for (int ks = 0; ks < 4; ++ks)
#pragma unroll
                for (int kb = 0; kb < 3; ++kb) Cacc[kb] = __builtin_amdgcn_mfma_f32_32x32x16_bf16(kwf[kb][ks], vf[ks], Cacc[kb], 0, 0, 0);
            if (!is_den) {
                float* hrow = hf + ((size_t)dir * M + (size_t)b * SEQ) * 768 + h * 192 + wave * 32 + r;
#pragma unroll
                for (int i = 0; i < 16; ++i) { const int lq = (i & 3) + 8 * (i >> 2) + 4 * hh, tp0 = c * 64 + lq, tp1 = tp0 + 32; const int t0 = dir ? SEQ - 1 - tp0 : tp0, t1 = dir ? SEQ - 1 - tp1 : tp1;
                    hrow[(unsigned)(t0 * 768)] = y0[i]; hrow[(unsigned)(t1 * 768)] = y1[i]; }
            } else if (r == 0) {
                float* drow = dn + ((size_t)dir * M + (size_t)b * SEQ) * 4 + h;
#pragma unroll
                for (int i = 0; i < 16; ++i) { const int lq = (i & 3) + 8 * (i >> 2) + 4 * hh, tp0 = c * 64 + lq, tp1 = tp0 + 32; const int t0 = dir ? SEQ - 1 - tp0 : tp0, t1 = dir ? SEQ - 1 - tp1 : tp1;
                    drow[(unsigned)(t0 * 4)] = fmaxf(fabsf(y0[i]), __expf(-(BB[tp0] + MM[tp0]))); drow[(unsigned)(t1 * 4)] = fmaxf(fabsf(y1[i]), __expf(-(BB[tp1] + MM[tp1]))); }
            }
        }
        ML_BAR();
        if (c + 1 < 64) ml_store(st, lds, c + 1, t);
        ML_BAR();
    }
}
__device__ __forceinline__ void mlstm_phase(KArgs a, int l, LAS unsigned char* lds, int wave, int ln) {
    for (int job = blockIdx.x; job < 64; job += gridDim.x) mlstm_job(a, l, lds, job, wave, ln);
    __syncthreads();
}

constexpr int PH_PER_LAYER = 11, N_PHASES = 1 + DEPTH * PH_PER_LAYER;
#ifndef MK_N_LAUNCHES
#define MK_N_LAUNCHES 1
#endif
#define lane (lane_id())
#define tid (wave * 64 + lane)
#define gw ((int)blockIdx.x * NWAVES + wave)
#define wsp() (kargs()->ws)
#define x_in ((const float*)kargs()->in[0])
#define xres ((bf16*)(wsp() + WS_XR))
#define HB ((bf16*)(wsp() + WS_HBUF))
#define YB ((bf16*)(wsp() + WS_YBUF))
#define YC ((bf16*)(wsp() + WS_YCAT))
#define PJ ((bf16*)(wsp() + WS_PROJ))
#define QM ((bf16*)(wsp() + WS_QMLA))
#define KVM ((bf16*)(wsp() + WS_KVMLA))
#define AB ((bf16*)(wsp() + WS_ABUF))
#define modp ((const float*)(wsp() + WS_MOD))
#define IN(k) (lo <= (k) && (k) < hi)
#define SEAM(k) do { if (IN(k) && IN((k) + 1)) xcd_barrier<false>(bar, tid == 0); } while (0)
#define SEAM0(k) do { if (IN(k) && IN((k) + 1)) xcd_barrier<true>(bar, tid == 0); } while (0)

template <int l> __device__ __forceinline__ void layer_phases(LAS unsigned char* lds, const XcdBarrier& bar, const int wave, const int lo, const int hi) {
    const int G = gridDim.x, NGW = G * NWAVES;
    constexpr int pb = 1 + l * PH_PER_LAYER;
#define wb (wsp() + WS_W + (size_t)l * W_LAYER)
#define modl (modp + (size_t)l * BATCH * NMOD)
    if (l == 0 && IN(pb + 0)) {
        const float* g = (const float*)kargs()->in[5] + l * DM; const int ln = lane;
        for (int r0 = blockIdx.x * 128; r0 < M; r0 += G * 128) { const int b = r0 / SEQ; const float* mb = modl + (size_t)b * NMOD;
            row_norm_wg<true, false, false, false, true>(lds, x_in, nullptr, nullptr, nullptr, nullptr, HB, g, mb + 1 * DM, mb + 0 * DM, r0, wave, ln); }
    }
    SEAM(pb + 0);
    if (IN(pb + 1)) {
        pg8::Gemm g{HB, (const bf16*)(wb + WO_IN), M, NINP, DM, DM}; pg8::StaticOrder S; S.init(M, NINP, G, (int)blockIdx.x);
        pg8::EpiBf16 E{PJ, NINP};
        pg8::gemm_phase<pg8::EpiBf16, pg8::StaticOrder, false, true>(lds + RING_OFF, g, S, E, wave);
    }
    SEAM(pb + 1);
    if (IN(pb + 2)) prep_rows(kargs(), wave, lane);
    SEAM(pb + 2);
    if (IN(pb + 3)) {
        { pg8::Gemm g{PJ + C_BCQ, (const bf16*)(wb + WO_UQ), M, NQB, QLP, NINP}; pg8::StaticOrder S; S.init(M, NQB, G, (int)blockIdx.x);
          pg8::EpiQRope E{QM, NQB, (const float*)(wsp() + WS_RSQ), QSCALE_B, (const float*)(wsp() + WS_COS), (const float*)(wsp() + WS_SIN)};
          pg8::gemm_phase<pg8::EpiQRope, pg8::StaticOrder, false, true>(lds + RING_OFF, g, S, E, wave); }
        __syncthreads();
        { pg8::Gemm g{PJ + C_BCKV, (const bf16*)(wb + WO_UKV), M, NKVB, KVL, NINP}; pg8::StaticOrder S; S.init(M, NKVB, G, (int)blockIdx.x);
          pg8::EpiRowScale E{KVM, NKVB, (const float*)(wsp() + WS_RSKV), 1.0f};
          pg8::gemm_phase<pg8::EpiRowScale, pg8::StaticOrder, false, true>(lds + RING_OFF, g, S, E, wave); }
    }
    SEAM(pb + 3);
    if (IN(pb + 4)) {
        __syncthreads();
        const int xl = blockIdx.x & 7; unsigned* qh = (unsigned*)(wsp() + WS_CTL) + CW_Q + 64 * (l * 8 + xl);
        volatile LAS unsigned* qw = (volatile LAS unsigned*)(lds + MISC_OFF) + 16;
        const bool t0 = (tid == 0);
        if (t0) qw[0] = __hip_atomic_fetch_add(qh, 1u, __ATOMIC_RELAXED, __HIP_MEMORY_SCOPE_AGENT);
        __syncthreads();
        for (;;) {
            const unsigned it = qw[0];
            if (it >= 264u) break;
            unsigned nxt = 0u; if (t0) nxt = __hip_atomic_fetch_add(qh, 1u, __ATOMIC_RELAXED, __HIP_MEMORY_SCOPE_AGENT);
            if (it < 8u) mlstm_job(kargs(), l, lds, xl * 8 + (int)it, wave, lane);
            else if (it < 72u) { const int v = (int)it - 8, bh = xl * 4 + (v >> 4), qb = v & 15;
                __syncthreads();
                mla_unit((const bf16*)(wsp() + WS_QMLA), (const bf16*)(wsp() + WS_KVMLA), (const bf16*)(wsp() + WS_KROPE), (bf16*)(wsp() + WS_YCAT), lds, bh >> 2, bh & 3, qb, wave, lane); }
            else if (it >= 264u) { const int ch = ((int)it - 264) * 8 + xl; __syncthreads(); if (ch < NDEF_CHUNKS) convert_deferred_chunk(kargs(), lds, ch, wave, lane); }
            else { const int v = (int)it - 72, u = xl * 192 + v, qb = u & 15, hq = (u >> 4) % 12, b = u / 192; const float* sink = (const float*)kargs()->in[10] + l * 12;
                win_unit((const bf16*)(wsp() + WS_PROJ), (bf16*)(wsp() + WS_YCAT), sink[hq] * LOG2E, ALIBI[hq] * LOG2E, lds, b, hq, qb, wave, lane); }
            __syncthreads();
            if (t0) qw[0] = nxt;
            __syncthreads();
        }
    }
    SEAM(pb + 4);
    if (IN(pb + 5)) mlstm_combine(kargs(), l, wave, lane);
    SEAM(pb + 5);
    if (IN(pb + 6)) {
        pg8::Gemm g{YC, (const bf16*)(wb + WO_OUT), M, DM, DM, DM}; pg8::StaticOrder S; S.init(M, DM, G, (int)blockIdx.x);
        pg8::EpiBf16 E{YB, DM};
        pg8::gemm_phase<pg8::EpiBf16, pg8::StaticOrder, false, true>(lds + RING_OFF, g, S, E, wave);
    }
    SEAM(pb + 6);
    if (IN(pb + 7)) {
        const float* gp = (const float*)kargs()->in[6] + l * DM; const float* g2 = (const float*)kargs()->in[7] + l * DM; const int ln = lane;
        for (int r0 = blockIdx.x * 128; r0 < M; r0 += G * 128) { const int b = r0 / SEQ; const float* mb = modl + (size_t)b * NMOD;
            if (l == 0) row_norm_wg<true, false, true, true, true>(lds, x_in, YB, mb + 2 * DM, gp, xres, HB, g2, mb + 4 * DM, mb + 3 * DM, r0, wave, ln);
            else row_norm_wg<false, false, true, true, true>(lds, xres, YB, mb + 2 * DM, gp, xres, HB, g2, mb + 4 * DM, mb + 3 * DM, r0, wave, ln); }
    }
    SEAM(pb + 7);
    if (IN(pb + 8)) {
        pg8::Gemm g{HB, (const bf16*)(wb + WO_GU), M, 2 * DFF, DM, DM}; pg8::StaticOrder S; S.init(M, 2 * DFF, G, (int)blockIdx.x);
        pg8::EpiSwiGLU E{AB, DFF};
        pg8::gemm_phase<pg8::EpiSwiGLU, pg8::StaticOrder, false, true>(lds + RING_OFF, g, S, E, wave);
    }
    SEAM(pb + 8);
    if (IN(pb + 9)) {
        pg8::Gemm g{AB, (const bf16*)(wb + WO_DN), M, DM, DFF, DFF}; pg8::StaticOrder S; S.init(M, DM, G, (int)blockIdx.x);
        pg8::EpiBf16 E{YB, DM};
        pg8::gemm_phase<pg8::EpiBf16, pg8::StaticOrder, false, true>(lds + RING_OFF, g, S, E, wave);
    }
    SEAM(pb + 9);
    if (IN(pb + 10)) {
        constexpr bool nxt = (l + 1 < DEPTH); constexpr int ln1 = nxt ? l + 1 : l;
        const float* gp = (const float*)kargs()->in[8] + l * DM; const float* g1n = (const float*)kargs()->in[5] + ln1 * DM; const float* modn = modp + (size_t)ln1 * BATCH * NMOD; const int ln = lane;
        for (int r0 = blockIdx.x * 128; r0 < M; r0 += G * 128) { const int b = r0 / SEQ; const float* mb = modl + (size_t)b * NMOD; const float* mbn = modn + (size_t)b * NMOD;
            if (nxt) row_norm_wg<false, false, true, true, true>(lds, xres, YB, mb + 5 * DM, gp, xres, HB, g1n, mbn + 1 * DM, mbn + 0 * DM, r0, wave, ln);
            else row_norm_wg<false, true, true, true, false>(lds, xres, YB, mb + 5 * DM, gp, kargs()->out, nullptr, nullptr, nullptr, nullptr, r0, wave, ln); }
    }
    if (l + 1 < DEPTH) SEAM(pb + 10);
#undef wb
#undef modl
}

__global__ void __launch_bounds__(NTHR, 2) fwd_kernel(Args args) {
    extern __shared__ __attribute__((aligned(16))) unsigned char lds_raw[];
    LAS unsigned char* lds = (LAS unsigned char*)lds_raw;
    volatile LAS unsigned* MISC = (volatile LAS unsigned*)(lds + MISC_OFF);
    const int wave = __builtin_amdgcn_readfirstlane((int)threadIdx.x >> 6);
    unsigned* ctl = (unsigned*)(kargs()->ws + WS_CTL);
    for (int u = (int)threadIdx.x; u < (LDS_BYTES - LDSCTL_OFF) / 4; u += NTHR) ((LAS unsigned*)(lds + LDSCTL_OFF))[u] = 0u;
    __syncthreads();
    XcdBarrier bar; bar.bar = ctl + CW_BAR; bar.x = 0; bar.st = nullptr;
#if MK_N_LAUNCHES == 1 && !defined(PROBE_LIST)
    constexpr int lo = 0, hi = N_PHASES;
#else
    const int lo = kargs()->ph_lo, hi = kargs()->ph_hi;
#endif
    if (hi - lo > 1) bar = xcd_barrier_post(ctl + CW_BAR, MISC + 8, tid == 0);
#ifdef PROBE_LIST
    if (lo >= 100) {
        if (lo == 100) mlstm_phase(kargs(), 0, lds, wave, lane);
        else if (lo == 101) mla_phase(kargs(), lds, wave, lane);
        else if (lo == 102) win_phase(kargs(), 0, lds, wave, lane);
        else if (lo == 103) p0_prologue<1>(kargs(), lds, wave, lane, tid);
        else if (lo == 104) p0_prologue<2>(kargs(), lds, wave, lane, tid);
        else if (lo == 105) p0_prologue<4>(kargs(), lds, wave, lane, tid);
        return;
    }
#endif
    if (IN(0)) { p0_prologue<7>(kargs(), lds, wave, lane, tid); }
    SEAM0(0);
    layer_phases<0>(lds, bar, wave, lo, hi);
    layer_phases<1>(lds, bar, wave, lo, hi);
}
#undef IN
#undef SEAM
#undef SEAM0
#undef lane
#undef tid
#undef gw

extern "C" void kernel_launch(void* const* d_in, const int* in_sizes, int n_in, void* d_out, int out_size, void* d_ws, size_t ws_size, hipStream_t stream) {
    static int grid = 0;
    if (grid == 0) {
        if (n_in != 21 || in_sizes[0] != M * DM || out_size != M * DM || ws_size < WS_END) { fprintf(stderr, "kernel_launch: unexpected shapes/workspace (n_in %d, in0 %d, out %d, ws %zu, need %zu)\n", n_in, n_in > 0 ? in_sizes[0] : -1, out_size, ws_size, (size_t)WS_END); grid = -1; return; }
        int dev = 0, cus = 0, per_cu = 0;
        if (hipGetDevice(&dev) != hipSuccess || hipDeviceGetAttribute(&cus, hipDeviceAttributeMultiprocessorCount, dev) != hipSuccess) { grid = -1; return; }
        if (hipFuncSetAttribute((const void*)fwd_kernel, hipFuncAttributeMaxDynamicSharedMemorySize, LDS_BYTES) != hipSuccess) { fprintf(stderr, "kernel_launch: hipFuncSetAttribute failed\n"); grid = -1; return; }
        if (hipOccupancyMaxActiveBlocksPerMultiprocessor(&per_cu, (const void*)fwd_kernel, NTHR, LDS_BYTES) != hipSuccess || per_cu < 1) fprintf(stderr, "kernel_launch: occupancy query reports %d\n", per_cu);
        (void)hipGetLastError();
        grid = cus;
    }
    if (grid < 0) return;
    (void)hipMemsetAsync((char*)d_ws + WS_CTL, 0, CTL_ZERO_BYTES, stream);
    Args a{};
    for (int i = 0; i < 21; ++i) a.in[i] = d_in[i];
    a.out = (float*)d_out; a.ws = (unsigned char*)d_ws;
    if (MK_N_LAUNCHES == 1) { a.ph_lo = 0; a.ph_hi = N_PHASES; hipLaunchKernelGGL(fwd_kernel, dim3(grid), dim3(NTHR), LDS_BYTES, stream, a);
#ifdef PROBE_LIST
        { const int pl[] = {PROBE_LIST}; for (int p : pl) { a.ph_lo = p; a.ph_hi = p + 1; hipLaunchKernelGGL(fwd_kernel, dim3(grid), dim3(NTHR), LDS_BYTES, stream, a); } }
#endif
    }
    else { for (int p = 0; p < N_PHASES; ++p) { a.ph_lo = p; a.ph_hi = p + 1; hipLaunchKernelGGL(fwd_kernel, dim3(grid), dim3(NTHR), LDS_BYTES, stream, a); } }
}
```

```cpp
#include <hip/hip_runtime.h>
#include <cstdio>
#include <cstdint>

constexpr int BATCH = 8, SEQ = 4096, DM = 2048, DEPTH = 2, M = BATCH * SEQ;
constexpr int NIN = 4240, NINP = 4352, DFF = 5632, NMOD = 6 * DM;
constexpr int C_AQ = 0, C_AK = 768, C_AV = 1024, C_BCQ = 1280, C_BCKV = 1728, C_BKR = 1856, C_CQ = 1920, C_CK = 2304, C_CV = 2688, C_CG = 3456, C_CO = 3472;
constexpr int QL = 448, QLP = 512, KVL = 128, NQB = 768, NKVB = 1024;
constexpr float EPS = 1e-6f;
constexpr float LOG2E = 1.4426950408889634f;
constexpr float QSCALE_A = 0.125f * 1.4426950408889634f;
constexpr float QSCALE_B = 0.10411754627697264f;
constexpr float QSCALE_C = 0.10206207261596575f;

namespace pg8 {
#define PG8_LAS __attribute__((address_space(3)))
typedef unsigned short bf16_t;
typedef short bf16x8 __attribute__((ext_vector_type(8)));
typedef float f32x4 __attribute__((ext_vector_type(4)));
typedef unsigned u32x4 __attribute__((ext_vector_type(4)));
constexpr int BM = 256, BK = 64, HALF = 128, HTB = HALF * BK * 2  , STAGE_BYTES = 8 * HTB, NXCD = 8, WGM = 8;

__host__ __device__ __forceinline__ int lds_byte(int r, int c) { const int st = (r >> 4) * 2 + (c >> 5), rr = r & 15, cc = c & 31, ob = rr * 64 + cc * 2; return st * 1024 + (ob ^ (((ob >> 9) & 1) << 5)); }
__host__ __device__ __forceinline__ void stage_rc(int b, int& R, int& C) { const int st = b / 1024, sb = b % 1024, swz = sb ^ (((sb >> 9) & 1) << 5); R = (st >> 1) * 16 + swz / 64; C = (st & 1) * 32 + (swz % 64) / 2; }
__host__ __device__ __forceinline__ int perm32(int rho) { const int n = rho >> 4, i = rho & 15; return 8 * (i >> 2) + 4 * n + (i & 3); }

struct Unit { int pm, pn; };
struct Gemm { const bf16_t* A; const bf16_t* Bt; int M, N, K, lda; };

struct StaticOrder {
    int nM, nN, nwg, G, c;
    __host__ __device__ void init(int M, int N, int G_, int c_) { nM = M / BM; nN = N / BM; nwg = nM * nN; G = G_; c = c_; }
    __host__ __device__ bool next(int i, Unit& u) const {
        const long L = (long)i * G + c; if (L >= nwg) return false;
        int wgid = (int)L; { const int q = nwg / NXCD, r = nwg % NXCD, xcd = wgid % NXCD, off = wgid / NXCD; wgid = (xcd < r ? xcd * (q + 1) : r * (q + 1) + (xcd - r) * q) + off; }
        const int nig = WGM * nN, gid = wgid / nig, fm = gid * WGM, gsz = (nM - fm) < WGM ? (nM - fm) : WGM;
        u.pm = fm + ((wgid % nig) % gsz); u.pn = (wgid % nig) / gsz; return true;
    }
    __device__ __forceinline__ void a_ready(const Unit&) const {}
    __device__ __forceinline__ void done(const Unit&) const {}
};
struct SubOrder {
    int nM, nN, nwg, G, c, base, cnt;
    __host__ __device__ void init(int M, int N, int G_, int c_, int base_, int cnt_) { nM = M / BM; nN = N / BM; nwg = nM * nN; G = G_; c = c_; base = base_; cnt = cnt_; }
    __host__ __device__ bool next(int i, Unit& u) const {
        if (i >= cnt) return false;
        const long L = (long)base + (long)i * G + c; if (L >= nwg) return false;
        int wgid = (int)L; { const int q = nwg / NXCD, r = nwg % NXCD, xcd = wgid % NXCD, off = wgid / NXCD; wgid = (xcd < r ? xcd * (q + 1) : r * (q + 1) + (xcd - r) * q) + off; }
        const int nig = WGM * nN, gid = wgid / nig, fm = gid * WGM, gsz = (nM - fm) < WGM ? (nM - fm) : WGM;
        u.pm = fm + ((wgid % nig) % gsz); u.pn = (wgid % nig) / gsz; return true;
    }
    __device__ __forceinline__ void a_ready(const Unit&) const {}
    __device__ __forceinline__ void done(const Unit&) const {}
};


__device__ __forceinline__ unsigned cvt_pk_bf16(float lo, float hi) { unsigned r; asm volatile("v_cvt_pk_bf16_f32 %0, %1, %2" : "=v"(r) : "v"(lo), "v"(hi)); return r; }

struct EpiBf16 {
    static constexpr bool PERM = true, AFTER_DRAIN = false;
    bf16_t* O; int ldc;
    __device__ __forceinline__ void operator()(const f32x4 (&acc)[2][2][4][2], const Unit& u, int wr, int wc, int fr, int fq) const {
        const int row0 = u.pm * BM + wr * 64 + fr; const int col0 = u.pn * BM + wc * 32 + 8 * fq;
#pragma unroll
        for (int ai = 0; ai < 2; ++ai)
#pragma unroll
            for (int m = 0; m < 4; ++m) { unsigned off = (unsigned)(row0 + ai * HALF + m * 16) * (unsigned)ldc + (unsigned)col0; asm volatile("" : "+v"(off)); bf16_t* rowp = O + off;
#pragma unroll
                for (int bj = 0; bj < 2; ++bj) { const f32x4 v0 = acc[ai][bj][m][0], v1 = acc[ai][bj][m][1];
                    u32x4 w; w.x = cvt_pk_bf16(v0[0], v0[1]); w.y = cvt_pk_bf16(v0[2], v0[3]); w.z = cvt_pk_bf16(v1[0], v1[1]); w.w = cvt_pk_bf16(v1[2], v1[3]);
                    *(u32x4*)(rowp + bj * HALF) = w; } }
    }
};
struct EpiRowScale {
    static constexpr bool PERM = true, AFTER_DRAIN = false;
    bf16_t* O; int ldc; const float* rs; float mul;
    __device__ __forceinline__ void operator()(const f32x4 (&acc)[2][2][4][2], const Unit& u, int wr, int wc, int fr, int fq) const {
        const int row0 = u.pm * BM + wr * 64 + fr; const int col0 = u.pn * BM + wc * 32 + 8 * fq;
#pragma unroll
        for (int ai = 0; ai < 2; ++ai)
#pragma unroll
            for (int m = 0; m < 4; ++m) { int row = row0 + ai * HALF + m * 16; asm volatile("" : "+v"(row)); const float sc = rs[row] * mul; bf16_t* rowp = O + ((unsigned)row * (unsigned)ldc + (unsigned)col0);
#pragma unroll
                for (int bj = 0; bj < 2; ++bj) { const f32x4 v0 = acc[ai][bj][m][0] * sc, v1 = acc[ai][bj][m][1] * sc;
                    u32x4 w; w.x = cvt_pk_bf16(v0[0], v0[1]); w.y = cvt_pk_bf16(v0[2], v0[3]); w.z = cvt_pk_bf16(v1[0], v1[1]); w.w = cvt_pk_bf16(v1[2], v1[3]);
                    *(u32x4*)(rowp + bj * HALF) = w; } }
    }
};
struct EpiQRope {
    static constexpr bool PERM = true, AFTER_DRAIN = false;
    bf16_t* O; int ldc; const float* rs; float mul; const float* cs; const float* sn;
    __device__ __forceinline__ void operator()(const f32x4 (&acc)[2][2][4][2], const Unit& u, int wr, int wc, int fr, int fq) const {
        const int row0 = u.pm * BM + wr * 64 + fr; const int col0 = u.pn * BM + wc * 32 + 8 * fq;
#pragma unroll
        for (int ai = 0; ai < 2; ++ai)
#pragma unroll
            for (int m = 0; m < 4; ++m) { int row = row0 + ai * HALF + m * 16; asm volatile("" : "+v"(row)); const float sc = rs[row] * mul; bf16_t* rowp = O + ((unsigned)row * (unsigned)ldc + (unsigned)col0);
#pragma unroll
                for (int bj = 0; bj < 2; ++bj) { f32x4 v0 = acc[ai][bj][m][0] * sc, v1 = acc[ai][bj][m][1] * sc;
                    const int hc = (col0 + bj * HALF) % 192;
                    if (hc >= 128) { const int i0 = (hc - 128) >> 1; const f32x4 c = *(const f32x4*)(cs + (unsigned)(row * 32 + i0)), s = *(const f32x4*)(sn + (unsigned)(row * 32 + i0));
                        const f32x4 a = v0, b = v1;
                        v0[0] = a[0] * c[0] - a[1] * s[0]; v0[1] = a[0] * s[0] + a[1] * c[0]; v0[2] = a[2] * c[1] - a[3] * s[1]; v0[3] = a[2] * s[1] + a[3] * c[1];
                        v1[0] = b[0] * c[2] - b[1] * s[2]; v1[1] = b[0] * s[2] + b[1] * c[2]; v1[2] = b[2] * c[3] - b[3] * s[3]; v1[3] = b[2] * s[3] + b[3] * c[3]; }
                    u32x4 w; w.x = cvt_pk_bf16(v0[0], v0[1]); w.y = cvt_pk_bf16(v0[2], v0[3]); w.z = cvt_pk_bf16(v1[0], v1[1]); w.w = cvt_pk_bf16(v1[2], v1[3]);
                    *(u32x4*)(rowp + bj * HALF) = w; } }
    }
};
struct EpiSwiGLU {
    static constexpr bool PERM = true, AFTER_DRAIN = false;
    bf16_t* O; int ldc;
    __device__ __forceinline__ void operator()(const f32x4 (&acc)[2][2][4][2], const Unit& u, int wr, int wc, int fr, int fq) const {
        const int row0 = u.pm * BM + wr * 64 + fr; const int col0 = u.pn * HALF + wc * 32 + 8 * fq;
#pragma unroll
        for (int ai = 0; ai < 2; ++ai)
#pragma unroll
            for (int m = 0; m < 4; ++m) { unsigned off = (unsigned)(row0 + ai * HALF + m * 16) * (unsigned)ldc + (unsigned)col0; asm volatile("" : "+v"(off)); bf16_t* rowp = O + off;
                float o[8];
#pragma unroll
                for (int n = 0; n < 2; ++n)
#pragma unroll
                    for (int j = 0; j < 4; ++j) { const float g = acc[ai][0][m][n][j], up = acc[ai][1][m][n][j];
                        const float e = __builtin_amdgcn_exp2f(-g * 1.4426950408889634f); o[n * 4 + j] = g * __builtin_amdgcn_rcpf(1.0f + e) * up; }
                u32x4 w; w.x = cvt_pk_bf16(o[0], o[1]); w.y = cvt_pk_bf16(o[2], o[3]); w.z = cvt_pk_bf16(o[4], o[5]); w.w = cvt_pk_bf16(o[6], o[7]);
                *(u32x4*)rowp = w; }
    }
};

template <class Epi, class Sched, bool ALIGN_EPI = false, bool SP2 = false>
__device__ __forceinline__ void gemm_phase(PG8_LAS unsigned char* lds, const Gemm g, const Sched& S, const Epi& E, const int wave_id) {
    int lane_ = (int)__builtin_amdgcn_mbcnt_hi(~0u, __builtin_amdgcn_mbcnt_lo(~0u, 0u)); asm volatile("" : "+v"(lane_));
    const int wid = wave_id, lane = lane_, tid = wid * 64 + lane, wr = wid >> 2, wc = wid & 3, fr = lane & 15, fq = lane >> 4;
    const int K = g.K, nt = K / BK;
    unsigned voffA[2], voffB[2];
#pragma unroll
    for (int i = 0; i < 2; ++i) { int R, C; stage_rc(tid * 16 + i * 8192, R, C); const int Rb = Epi::PERM ? ((R & ~31) + perm32(R & 31)) : R;
        voffA[i] = (unsigned)(R * g.lda + C) * 2u; voffB[i] = (unsigned)(Rb * K + C) * 2u; }
    const size_t kstep = (size_t)(BK * 2);
    const size_t hstepA = (size_t)HALF * g.lda * 2, hstepB = (size_t)HALF * K * 2;
    const size_t tstepA = 2 * hstepA, tstepB = 2 * hstepB;
    const unsigned ldsw = (unsigned)wid * 1024u;
    const int aoff = lds_byte(wr * 64 + fr, fq * 8), boff = lds_byte(wc * 32 + fr, fq * 8);
#define PG8_SA(b, h) (((b) * 2 + (h)) * HTB)
#define PG8_SB(b, h) ((4 + (b) * 2 + (h)) * HTB)
#define PG8_STAGE(bufoff, gbase, voff) do { _Pragma("unroll") for (int _i = 0; _i < 2; ++_i) \
        __builtin_amdgcn_global_load_lds((const unsigned*)((const char*)(gbase) + (voff)[_i]), (PG8_LAS unsigned*)(lds + (bufoff) + ldsw + _i * 8192), 16, 0, 0); } while (0)
#define PG8_LDA(dst, b, h) do { _Pragma("unroll") for (int m = 0; m < 4; ++m) _Pragma("unroll") for (int k = 0; k < 2; ++k) dst[m][k] = *(const PG8_LAS bf16x8*)(lds + PG8_SA(b, h) + aoff + m * 2048 + k * 1024); } while (0)
#define PG8_LDB(dst, b, h) do { _Pragma("unroll") for (int n = 0; n < 2; ++n) _Pragma("unroll") for (int k = 0; k < 2; ++k) dst[n][k] = *(const PG8_LAS bf16x8*)(lds + PG8_SB(b, h) + boff + n * 2048 + k * 1024); } while (0)
#define PG8_MMA(ai, bj, At, Bt) do { __builtin_amdgcn_s_setprio(1); _Pragma("unroll") for (int m = 0; m < 4; ++m) _Pragma("unroll") for (int n = 0; n < 2; ++n) _Pragma("unroll") for (int k = 0; k < 2; ++k) \
        acc[ai][bj][m][n] = __builtin_amdgcn_mfma_f32_16x16x32_bf16(Bt[n][k], At[m][k], acc[ai][bj][m][n], 0, 0, 0); __builtin_amdgcn_s_setprio(0); } while (0)
#define PG8_WAIT_V(n) asm volatile("s_waitcnt vmcnt(" #n ")" ::: "memory")
#define PG8_WAIT_L(n) asm volatile("s_waitcnt lgkmcnt(" #n ")" ::: "memory")
#define PG8_BAR __builtin_amdgcn_s_barrier()
#define PG8_SCHED __builtin_amdgcn_sched_barrier(0)
    Unit cur, nxt; int ui = 0;
    if (!S.next(0, cur)) return;
    f32x4 acc[2][2][4][2];
#pragma unroll
    for (int a = 0; a < 2; ++a)
#pragma unroll
        for (int b = 0; b < 2; ++b)
#pragma unroll
            for (int m = 0; m < 4; ++m)
#pragma unroll
                for (int n = 0; n < 2; ++n) acc[a][b][m][n] = (f32x4){0.f, 0.f, 0.f, 0.f};
    bf16x8 At[4][2], B0[2][2], B1[2][2];
    const char* cA = (const char*)g.A + (size_t)cur.pm * tstepA; const char* cB = (const char*)g.Bt + (size_t)cur.pn * tstepB;
    S.a_ready(cur);
    if constexpr (SP2) {
        PG8_STAGE(PG8_SB(0, 0), cB, voffB); PG8_STAGE(PG8_SB(0, 1), cB + hstepB, voffB); PG8_STAGE(PG8_SA(0, 0), cA, voffA); PG8_STAGE(PG8_SA(0, 1), cA + hstepA, voffA);
        if (wr == 1) PG8_BAR;
        PG8_WAIT_V(2); PG8_BAR;
        PG8_STAGE(PG8_SB(1, 0), cB + kstep, voffB); PG8_STAGE(PG8_SA(1, 0), cA + kstep, voffA); PG8_STAGE(PG8_SB(1, 1), cB + hstepB + kstep, voffB);
        PG8_WAIT_V(6); PG8_BAR;
    } else {
        PG8_STAGE(PG8_SB(0, 0), cB, voffB); PG8_STAGE(PG8_SA(0, 0), cA, voffA); PG8_STAGE(PG8_SB(0, 1), cB + hstepB, voffB); PG8_STAGE(PG8_SA(0, 1), cA + hstepA, voffA);
        if (wr == 1) PG8_BAR;
        PG8_WAIT_V(4); PG8_BAR;
        PG8_STAGE(PG8_SB(1, 0), cB + kstep, voffB); PG8_STAGE(PG8_SA(1, 0), cA + kstep, voffA); PG8_STAGE(PG8_SB(1, 1), cB + hstepB + kstep, voffB);
        PG8_WAIT_V(6); PG8_BAR;
    }
    for (;;) {
        const bool has_next = S.next(ui + 1, nxt);
        const char* nA = has_next ? (const char*)g.A + (size_t)nxt.pm * tstepA : cA; const char* nB = has_next ? (const char*)g.Bt + (size_t)nxt.pn * tstepB : cB;
        for (int t = 0; t < nt; t += 2) {
            const bool last = (t == nt - 2);
            const char* a1 = cA + (size_t)(t + 1) * kstep;
            const char* a2 = last ? nA : cA + (size_t)(t + 2) * kstep; const char* b2 = last ? nB : cB + (size_t)(t + 2) * kstep;
            const char* a3 = a2 + kstep; const char* b3 = b2 + kstep;
            if (last && has_next) S.a_ready(nxt);
            if constexpr (SP2) {
            PG8_LDB(B0, 0, 0); PG8_LDB(B1, 0, 1); PG8_SCHED; PG8_LDA(At, 0, 0); PG8_STAGE(PG8_SA(1, 1), a1 + hstepA, voffA);
            PG8_WAIT_V(8); PG8_WAIT_L(0); PG8_BAR; PG8_MMA(0, 0, At, B0); PG8_MMA(0, 1, At, B1); PG8_BAR; PG8_SCHED;
            PG8_LDA(At, 0, 1); PG8_STAGE(PG8_SB(0, 0), b2, voffB); PG8_STAGE(PG8_SB(0, 1), b2 + hstepB, voffB); PG8_STAGE(PG8_SA(0, 0), a2, voffA);
            PG8_WAIT_V(8); PG8_WAIT_L(0); PG8_BAR; PG8_MMA(1, 0, At, B0); PG8_MMA(1, 1, At, B1); PG8_BAR; PG8_SCHED;
            PG8_LDB(B0, 1, 0); PG8_LDB(B1, 1, 1); PG8_SCHED; PG8_LDA(At, 1, 0); PG8_STAGE(PG8_SA(0, 1), a2 + hstepA, voffA);
            PG8_WAIT_V(8); PG8_WAIT_L(0); PG8_BAR; PG8_MMA(0, 0, At, B0); PG8_MMA(0, 1, At, B1); PG8_BAR; PG8_SCHED;
            PG8_LDA(At, 1, 1); PG8_STAGE(PG8_SB(1, 0), b3, voffB); PG8_STAGE(PG8_SB(1, 1), b3 + hstepB, voffB); PG8_STAGE(PG8_SA(1, 0), a3, voffA);
            PG8_WAIT_V(8); PG8_WAIT_L(0); PG8_BAR; PG8_MMA(1, 0, At, B0); PG8_MMA(1, 1, At, B1); PG8_BAR; PG8_SCHED;
            } else {
            PG8_LDB(B0, 0, 0); PG8_SCHED; PG8_LDA(At, 0, 0); PG8_STAGE(PG8_SA(1, 1), a1 + hstepA, voffA);
            PG8_WAIT_L(8); PG8_BAR; PG8_WAIT_L(0); PG8_MMA(0, 0, At, B0); PG8_BAR; PG8_SCHED;
            PG8_LDB(B1, 0, 1); PG8_STAGE(PG8_SB(0, 0), b2, voffB);
            PG8_BAR; PG8_WAIT_L(0); PG8_MMA(0, 1, At, B1); PG8_BAR;
            PG8_LDA(At, 0, 1); PG8_STAGE(PG8_SA(0, 0), a2, voffA);
            PG8_BAR; PG8_WAIT_L(0); PG8_MMA(1, 0, At, B0); PG8_BAR; PG8_SCHED;
            PG8_STAGE(PG8_SB(0, 1), b2 + hstepB, voffB);
            PG8_WAIT_V(6); PG8_BAR; PG8_MMA(1, 1, At, B1); PG8_BAR;
            PG8_LDB(B0, 1, 0); PG8_SCHED; PG8_LDA(At, 1, 0); PG8_STAGE(PG8_SA(0, 1), a2 + hstepA, voffA);
            PG8_WAIT_L(8); PG8_BAR; PG8_WAIT_L(0); PG8_MMA(0, 0, At, B0); PG8_BAR; PG8_SCHED;
            PG8_LDB(B1, 1, 1); PG8_STAGE(PG8_SB(1, 0), b3, voffB);
            PG8_BAR; PG8_WAIT_L(0); PG8_MMA(0, 1, At, B1); PG8_BAR;
            PG8_LDA(At, 1, 1); PG8_STAGE(PG8_SA(1, 0), a3, voffA);
            PG8_BAR; PG8_WAIT_L(0); PG8_MMA(1, 0, At, B0); PG8_BAR; PG8_SCHED;
            PG8_STAGE(PG8_SB(1, 1), b3 + hstepB, voffB);
            PG8_WAIT_V(6); PG8_BAR; PG8_MMA(1, 1, At, B1); PG8_BAR;
            }
        }
        if constexpr (ALIGN_EPI) { if (wr == 0) PG8_BAR; }
        if constexpr (!Epi::AFTER_DRAIN) { E(acc, cur, wr, wc, fr, fq); S.done(cur); }
        if (!has_next) break;
#pragma unroll
        for (int a = 0; a < 2; ++a)
#pragma unroll
            for (int b = 0; b < 2; ++b)
#pragma unroll
                for (int m = 0; m < 4; ++m)
#pragma unroll
                    for (int n = 0; n < 2; ++n) acc[a][b][m][n] = (f32x4){0.f, 0.f, 0.f, 0.f};
        cur = nxt; cA = nA; cB = nB; ++ui;
        if constexpr (ALIGN_EPI) { if (wr == 1) PG8_BAR; }
    }
    PG8_WAIT_V(0);
    if constexpr (!ALIGN_EPI) { if (wr == 0) PG8_BAR; }
    PG8_BAR;
    if constexpr (Epi::AFTER_DRAIN) { E.fused(acc, cur, wr, wc, fr, fq, lds, wid, lane); S.done(cur); }
#undef PG8_SA
#undef PG8_SB
#undef PG8_STAGE
#undef PG8_LDA
#undef PG8_LDB
#undef PG8_MMA
#undef PG8_WAIT_V
#undef PG8_WAIT_L
#undef PG8_BAR
#undef PG8_SCHED
}
}
#define GAS __attribute__((address_space(1)))
#define LAS __attribute__((address_space(3)))
typedef unsigned short bf16;
typedef unsigned v4u __attribute__((ext_vector_type(4)));
typedef float f32x4 __attribute__((ext_vector_type(4)));
typedef short bf16x8 __attribute__((ext_vector_type(8)));
typedef unsigned v2u __attribute__((ext_vector_type(2)));
typedef GAS unsigned gu32;
typedef GAS unsigned long long gu64;
#define RLX_AGENT __ATOMIC_RELAXED, __HIP_MEMORY_SCOPE_AGENT
#define LDS_WAIT() asm volatile("s_waitcnt lgkmcnt(0)" ::: "memory")
#define VM_WAIT() asm volatile("s_waitcnt vmcnt(0)" ::: "memory")
__device__ __forceinline__ unsigned long long rt() { return __builtin_amdgcn_s_memrealtime(); }
__device__ __forceinline__ unsigned f2bf(float f) { unsigned u = __builtin_bit_cast(unsigned, f); return (u + 0x7fffu + ((u >> 16) & 1u)) >> 16; }
__device__ __forceinline__ unsigned pk2(float lo, float hi) { return f2bf(lo) | (f2bf(hi) << 16); }
#define XB_TMO      128
#define XB_XCNT(j)  (256  + 64 * (j))
#define XB_XSUB(j)  (1280 + 64 * (j))
#define XB_XGEN(j)  (2304 + 64 * (j))
#define XB_TOP      3328
#define XB_TOPGEN   3392
#define XCD_BAR_WORDS 3456
#define XB_SPIN_CAP (1u << 18)

__device__ __forceinline__ unsigned xb_ld(unsigned* p)              { return __hip_atomic_load(p, __ATOMIC_RELAXED, __HIP_MEMORY_SCOPE_AGENT); }
__device__ __forceinline__ unsigned xb_add(unsigned* p, unsigned v) { return __hip_atomic_fetch_add(p, v, __ATOMIC_RELAXED, __HIP_MEMORY_SCOPE_AGENT); }
__device__ __forceinline__ unsigned xb_xcc_id() { return (unsigned)__builtin_amdgcn_s_getreg((3 << 11) | 20) & 0xFu; }
#define XB_SPIN(cond, bar) do { unsigned _sp = 0; while (cond) { __builtin_amdgcn_s_sleep(1); \
    if ((++_sp & 255u) == 0u) { if (xb_ld(&(bar)[XB_TMO])) break; if (_sp > XB_SPIN_CAP) { atomicAdd(&(bar)[XB_TMO], 1u); break; } } } } while (0)

struct XcdBarrier {
    unsigned* bar; unsigned x;
    volatile LAS unsigned* st;
};

__device__ __forceinline__ XcdBarrier xcd_barrier_post(unsigned* bar, volatile LAS unsigned* st, const bool t0) {
    XcdBarrier b; b.bar = bar; b.x = xb_xcc_id(); b.st = st;
    if (t0) (void)xb_add(&bar[XB_XCNT(b.x)], 1u);
    return b;
}
__device__ __forceinline__ void xcd_barrier_complete(unsigned* bar, unsigned x, unsigned& nloc, unsigned& nx) {
    const unsigned G = gridDim.x * gridDim.y * gridDim.z;
    unsigned sum, cnt, mine, sp = 0u;
    for (;;) {
        sum = 0u; cnt = 0u; mine = 0u;
#pragma unroll
        for (unsigned j = 0; j < 16; ++j) { const unsigned c = xb_ld(&bar[XB_XCNT(j)]); sum += c; cnt += (c > 0u) ? 1u : 0u; mine = (j == x) ? c : mine; }
        if (sum == G) break;
        __builtin_amdgcn_s_sleep(1);
        if ((++sp & 255u) == 0u) { if (xb_ld(&bar[XB_TMO])) break; if (sp > XB_SPIN_CAP) { atomicAdd(&bar[XB_TMO], 1u); break; } }
    }
    nloc = mine > 0u ? mine : 1u; nx = cnt > 0u ? cnt : 1u;
}

template <bool FIRST> __device__ __forceinline__ void xcd_barrier(const XcdBarrier& b, const bool t0) {
    asm volatile("s_waitcnt vmcnt(0)" ::: "memory");
    __syncthreads();
    if (t0) {
        unsigned* bar = b.bar; unsigned bx = b.x; asm volatile("" : "+s"(bar), "+s"(bx));
        __builtin_amdgcn_s_waitcnt(0);
        unsigned nloc = b.st[0], nx = b.st[1];
        if constexpr (FIRST) { if (nloc == 0u) { xcd_barrier_complete(bar, bx, nloc, nx); b.st[0] = nloc; b.st[1] = nx; } }
        const unsigned old = xb_add(&bar[XB_XSUB(bx)], 1u);
        const unsigned gen = old / nloc;
        if (old + 1u == (gen + 1u) * nloc) {
            __builtin_amdgcn_fence(__ATOMIC_RELEASE, "agent");
            asm volatile("s_waitcnt vmcnt(0)" ::: "memory");
            const unsigned og = xb_add(&bar[XB_TOP], 1u);
            const unsigned tg = og / nx;
            if (og + 1u == (tg + 1u) * nx) xb_add(&bar[XB_TOPGEN], 1u);
            else XB_SPIN(xb_ld(&bar[XB_TOPGEN]) == tg, bar);
            __builtin_amdgcn_fence(__ATOMIC_ACQUIRE, "agent");
            xb_add(&bar[XB_XGEN(bx)], 1u);
            asm volatile("s_waitcnt vmcnt(0)" ::: "memory");
        } else {
            XB_SPIN(xb_ld(&bar[XB_XGEN(bx)]) == gen, bar);
            __builtin_amdgcn_fence(__ATOMIC_ACQUIRE, "agent");
            asm volatile("s_waitcnt vmcnt(0)" ::: "memory");
        }
    }
    __syncthreads();
}

constexpr size_t MiB = 1u << 20;
constexpr size_t WS_CTL = 0, CTL_ZERO_BYTES = 1 * MiB;
constexpr size_t WS_MOD = 1 * MiB;
constexpr size_t WS_COS = 2 * MiB, WS_SIN = 6 * MiB;
constexpr size_t WS_RSQ = 10 * MiB, WS_RSKV = 10 * MiB + 512 * 1024;
constexpr size_t WS_KROPE = 11 * MiB;
constexpr size_t WS_GPREP = 15 * MiB;
constexpr size_t WS_W = 24 * MiB, W_LAYER = 92 * MiB;
constexpr size_t WO_IN = 0, WO_UQ = 17 * MiB, WO_UKV = 17 * MiB + 768 * 1024, WO_OUT = 18 * MiB, WO_GU = 26 * MiB, WO_DN = 70 * MiB;
constexpr size_t WS_HBUF = 208 * MiB;
constexpr size_t WS_YBUF = 336 * MiB;
constexpr size_t WS_YCAT = WS_HBUF;
constexpr size_t WS_XR = 464 * MiB;
constexpr size_t WS_PROJ = 592 * MiB;
constexpr size_t WS_QMLA = 864 * MiB;
constexpr size_t WS_KVMLA = 912 * MiB;
constexpr size_t WS_ABUF = WS_PROJ;
constexpr size_t WS_END = 976 * MiB;
static_assert(WS_W + 2 * W_LAYER <= WS_HBUF && WS_XR + (size_t)M * DM * 2 <= WS_PROJ && WS_ABUF + (size_t)M * DFF * 2 <= WS_END && (size_t)2 * M * 768 * 4 <= (size_t)M * DM * 4, "d_ws map");
static_assert(WO_IN + (size_t)NINP * DM * 2 <= WO_UQ && WO_UQ + (size_t)NQB * QLP * 2 <= WO_UKV && WO_UKV + (size_t)NKVB * KVL * 2 <= WO_OUT && WO_OUT + (size_t)DM * DM * 2 <= WO_GU && WO_GU + (size_t)2 * DFF * DM * 2 <= WO_DN && WO_DN + (size_t)DM * DFF * 2 <= W_LAYER, "weight map");
constexpr int CW_BAR = 4096;
constexpr int CW_Q = 16384;

constexpr int RING_OFF = 0, RING_BYTES = 131072;
constexpr int LDSCTL_OFF = RING_BYTES, MISC_OFF = LDSCTL_OFF + 320;
constexpr int LDS_BYTES = 147456;
constexpr int NWAVES = 8, NTHR = 512;

__device__ __forceinline__ float wave_sum(float v) {
#pragma unroll
    for (int o = 1; o < 64; o <<= 1) v += __shfl_xor(v, o);
    return v;
}
__device__ __forceinline__ float bf2f(unsigned short b) { return __builtin_bit_cast(float, (unsigned)b << 16); }
__device__ __forceinline__ float bflo(unsigned w) { return __builtin_bit_cast(float, w << 16); }
__device__ __forceinline__ float bfhi(unsigned w) { return __builtin_bit_cast(float, w & 0xffff0000u); }

__constant__ double INVF[32] = {1.0, 0.7498942093324559, 0.5623413251903491, 0.4216965034285822, 0.31622776601683794, 0.23713737056616552, 0.1778279410038923, 0.1333521432163324, 0.1, 0.07498942093324558, 0.05623413251903491, 0.042169650342858224, 0.03162277660168379, 0.023713737056616554, 0.01778279410038923, 0.01333521432163324, 0.01, 0.007498942093324558, 0.005623413251903491, 0.004216965034285823, 0.0031622776601683794, 0.0023713737056616554, 0.0017782794100389228, 0.001333521432163324, 0.001, 0.0007498942093324559, 0.0005623413251903491, 0.00042169650342858224, 0.00031622776601683794, 0.00023713737056616554, 0.00017782794100389227, 0.0001333521432163324};
__constant__ float ALIBI[12] = {0.5f, 0.25f, 0.125f, 0.0625f, 0.03125f, 0.015625f, 0.0078125f, 0.00390625f, 0.7071067690849304f, 0.3535533845424652f, 0.1767766922712326f, 0.0883883461356163f};

__device__ __forceinline__ int lane_id() { int l = (int)__builtin_amdgcn_mbcnt_hi(~0u, __builtin_amdgcn_mbcnt_lo(~0u, 0u)); asm volatile("" : "+v"(l)); return l; }
struct Args { const void* in[21]; float* out; unsigned char* ws; int ph_lo, ph_hi; };
typedef const __attribute__((address_space(4))) Args* KArgs;
__device__ __forceinline__ KArgs kargs() { KArgs p = (KArgs)__builtin_amdgcn_kernarg_segment_ptr(); asm volatile("" : "+s"(p)); return p; }

enum { WK_IN = 0, WK_UQ, WK_UKV, WK_OUT, WK_GATE, WK_UP, WK_DN };
__device__ __forceinline__ int wk_row(int kind, int n) {
    if (kind == WK_UQ) { const int hd = n / 192, hc = n % 192; if (hc < 128) return n; const int i = hc - 128; return hd * 192 + 128 + (i < 32 ? 2 * i : 2 * (i - 32) + 1); }
    if (kind == WK_GATE) return (n >> 7) * 256 + (n & 127);
    if (kind == WK_UP) return (n >> 7) * 256 + 128 + (n & 127);
    return n;
}
__device__ __forceinline__ float wk_colscale(int kind, int n) {
    if (kind == WK_IN) { if (n < C_AK) return QSCALE_A; if (n >= C_CQ && n < C_CK) return QSCALE_C; }
    return 1.0f;
}
__device__ __forceinline__ void transpose_item(const float* W, int K, int N, bf16* WT, int ldt, int kind, const float* rowg, LAS float* scr, int item, int lane) {
    const int nblk = (N + 31) / 32, kb = item / nblk, nb = item % nblk, k0 = 64 * kb, n0 = 32 * nb;
    { const int c4 = lane & 7, rr = lane >> 3, n = n0 + 4 * c4; f32x4 v[8];
#pragma unroll
      for (int i = 0; i < 8; ++i) { v[i] = (f32x4){0.f, 0.f, 0.f, 0.f}; if (n < N) v[i] = *(const GAS f32x4*)(W + (size_t)(k0 + 8 * i + rr) * N + n); }
      const float c0 = wk_colscale(kind, n), c1 = wk_colscale(kind, n + 1), c2 = wk_colscale(kind, n + 2), c3 = wk_colscale(kind, n + 3);
#pragma unroll
      for (int i = 0; i < 8; ++i) { const int kk = 8 * i + rr; const float g = rowg ? rowg[k0 + kk] : 1.0f; LAS float* d = scr + kk * 33 + 4 * c4;
          d[0] = v[i][0] * c0 * g; d[1] = v[i][1] * c1 * g; d[2] = v[i][2] * c2 * g; d[3] = v[i][3] * c3 * g; } }
    LDS_WAIT(); asm volatile("" ::: "memory");
    const int c = lane & 7;
#pragma unroll
    for (int j = 0; j < 4; ++j) { const int nl = (lane >> 3) + 8 * j; const LAS float* s = scr + (8 * c) * 33 + nl; const int drow = wk_row(kind, n0 + nl);
        v4u o; o.x = pk2(s[0 * 33], s[1 * 33]); o.y = pk2(s[2 * 33], s[3 * 33]); o.z = pk2(s[4 * 33], s[5 * 33]); o.w = pk2(s[6 * 33], s[7 * 33]);
        *(GAS v4u*)(WT + (size_t)drow * ldt + k0 + 8 * c) = o; }
    LDS_WAIT(); asm volatile("" ::: "memory");
}
__device__ __forceinline__ void sincos_rev(double r, float& sn, float& cs) {
    const double k = __builtin_rint(4.0 * r); const double f = r - 0.25 * k; const double y = 6.283185307179586476925 * f; const double y2 = y * y;
    double s = y * (1.0 + y2 * (-1.0 / 6 + y2 * (1.0 / 120 + y2 * (-1.0 / 5040 + y2 * (1.0 / 362880 + y2 * (-1.0 / 39916800 + y2 * (1.0 / 6227020800.0)))))));
    double c = 1.0 + y2 * (-0.5 + y2 * (1.0 / 24 + y2 * (-1.0 / 720 + y2 * (1.0 / 40320 + y2 * (-1.0 / 3628800 + y2 * (1.0 / 479001600.0 + y2 * (-1.0 / 87178291200.0)))))));
    const int q = ((int)k) & 3; double ss, cc;
    if (q == 0) { ss = s; cc = c; } else if (q == 1) { ss = c; cc = -s; } else if (q == 2) { ss = -s; cc = -c; } else { ss = -c; cc = s; }
    sn = (float)ss; cs = (float)cc;
}

struct RowRegs { f32x4 xf[8]; v2u xb[8]; v2u y[8]; };
template <bool XIN_F32, bool HAS_BR> __device__ __forceinline__ void row_load(RowRegs& R, const void* xin, const bf16* br, int lane) {
    if (XIN_F32) {
#pragma unroll
        for (int j = 0; j < 8; ++j) R.xf[j] = __builtin_nontemporal_load((const GAS f32x4*)((const float*)xin + 4 * (64 * j + lane)));
    } else {
#pragma unroll
        for (int j = 0; j < 8; ++j) R.xb[j] = __builtin_nontemporal_load((const GAS v2u*)((const bf16*)xin + 4 * (64 * j + lane)));
    }
    if (HAS_BR) {
#pragma unroll
        for (int j = 0; j < 8; ++j) R.y[j] = __builtin_nontemporal_load((const GAS v2u*)(br + 4 * (64 * j + lane)));
    }
}
template <bool XIN_F32, bool XOUT_F32, bool HAS_BR, bool HAS_X, bool HAS_H>
__device__ __forceinline__ void row_compute(const RowRegs& R, const LAS float* cst, void* xout, bf16* hout, int lane) {
    f32x4 v[8];
    if (XIN_F32) {
#pragma unroll
        for (int j = 0; j < 8; ++j) v[j] = R.xf[j];
    } else {
#pragma unroll
        for (int j = 0; j < 8; ++j) v[j] = (f32x4){bflo(R.xb[j].x), bfhi(R.xb[j].x), bflo(R.xb[j].y), bfhi(R.xb[j].y)};
    }
    if (HAS_BR) {
        f32x4 y[8]; float ss = 0.f;
#pragma unroll
        for (int j = 0; j < 8; ++j) { y[j] = (f32x4){bflo(R.y[j].x), bfhi(R.y[j].x), bflo(R.y[j].y), bfhi(R.y[j].y)}; ss += (y[j][0] * y[j][0] + y[j][1] * y[j][1]) + (y[j][2] * y[j][2] + y[j][3] * y[j][3]); }
        const float rstd = 1.0f / sqrtf(wave_sum(ss) * (1.0f / DM) + EPS);
#pragma unroll
        for (int j = 0; j < 8; ++j) v[j] = v[j] + *(const LAS f32x4*)(cst + 4 * (64 * j + lane)) * (y[j] * rstd);
    }
    if (HAS_X) {
        if (XOUT_F32) {
#pragma unroll
            for (int j = 0; j < 8; ++j) __builtin_nontemporal_store(v[j], (GAS f32x4*)((float*)xout + 4 * (64 * j + lane)));
        } else {
#pragma unroll
            for (int j = 0; j < 8; ++j) { v2u w; w.x = pk2(v[j][0], v[j][1]); w.y = pk2(v[j][2], v[j][3]); *(GAS v2u*)((bf16*)xout + 4 * (64 * j + lane)) = w;
                v[j] = (f32x4){bflo(w.x), bfhi(w.x), bflo(w.y), bfhi(w.y)}; }
        }
    }
    if (HAS_H) {
        float ss = 0.f;
#pragma unroll
        for (int j = 0; j < 8; ++j) ss += (v[j][0] * v[j][0] + v[j][1] * v[j][1]) + (v[j][2] * v[j][2] + v[j][3] * v[j][3]);
        const float rstd = 1.0f / sqrtf(wave_sum(ss) * (1.0f / DM) + EPS);
#pragma unroll
        for (int j = 0; j < 8; ++j) { const f32x4 h = v[j] * rstd * *(const LAS f32x4*)(cst + DM + 4 * (64 * j + lane)) + *(const LAS f32x4*)(cst + 2 * DM + 4 * (64 * j + lane));
            v2u w; w.x = pk2(h[0], h[1]); w.y = pk2(h[2], h[3]); *(GAS v2u*)(hout + 4 * (64 * j + lane)) = w; }
    }
}
template <bool XIN_F32, bool XOUT_F32, bool HAS_BR, bool HAS_X, bool HAS_H>
__device__ __forceinline__ void row_norm_wg(LAS unsigned char* lds, const void* xin, const bf16* br, const float* gate, const float* gpost, void* xout, bf16* hout, const float* gpre, const float* scale, const float* shift, int row0, int wave, int lane) {
    LAS float* cst = (LAS float*)lds;
    __syncthreads();
    { const int c = 4 * (wave * 64 + lane);
      if (HAS_BR) *(LAS f32x4*)(cst + c) = *(const GAS f32x4*)(gate + c) * *(const GAS f32x4*)(gpost + c);
      if (HAS_H) { *(LAS f32x4*)(cst + DM + c) = *(const GAS f32x4*)(gpre + c) * (*(const GAS f32x4*)(scale + c) + 1.0f); *(LAS f32x4*)(cst + 2 * DM + c) = *(const GAS f32x4*)(shift + c); } }
    const int m0 = row0 + wave * 16;
    const size_t xs = XIN_F32 ? 4 : 2, os = XOUT_F32 ? 4 : 2;
    if (XIN_F32) {
        RowRegs A;
        __syncthreads();
#pragma unroll 1
        for (int r = 0; r < 16; ++r) { const size_t ma = (size_t)(m0 + r);
            row_load<XIN_F32, HAS_BR>(A, (const char*)xin + ma * DM * xs, br + ma * DM, lane);
            row_compute<XIN_F32, XOUT_F32, HAS_BR, HAS_X, HAS_H>(A, cst, (char*)xout + ma * DM * os, hout + ma * DM, lane); }
    } else {
        RowRegs A, B;
        row_load<XIN_F32, HAS_BR>(A, (const char*)xin + (size_t)m0 * DM * xs, br + (size_t)m0 * DM, lane);
        __syncthreads();
#pragma unroll 1
        for (int r = 0; r < 16; r += 2) {
            const size_t ma = (size_t)(m0 + r), mb = ma + 1, mc = ma + 2;
            row_load<XIN_F32, HAS_BR>(B, (const char*)xin + mb * DM * xs, br + mb * DM, lane);
            row_compute<XIN_F32, XOUT_F32, HAS_BR, HAS_X, HAS_H>(A, cst, (char*)xout + ma * DM * os, hout + ma * DM, lane);
            if (r + 2 < 16) row_load<XIN_F32, HAS_BR>(A, (const char*)xin + mc * DM * xs, br + mc * DM, lane);
            row_compute<XIN_F32, XOUT_F32, HAS_BR, HAS_X, HAS_H>(B, cst, (char*)xout + mb * DM * os, hout + mb * DM, lane);
        }
    }
}

struct WDesc { const float* W; int K, N; bf16* WT; int ldt, kind; const float* rowg; int nitems; };
__device__ __forceinline__ void wdesc_layer(KArgs a, int l, WDesc (&d)[7]) {
    unsigned char* wb = a->ws + WS_W + (size_t)l * W_LAYER;
    d[0] = WDesc{(const float*)a->in[9] + (size_t)l * DM * NIN, DM, NIN, (bf16*)(wb + WO_IN), DM, WK_IN, nullptr, 0};
    d[1] = WDesc{(const float*)a->in[12] + (size_t)l * QL * NQB, QL, NQB, (bf16*)(wb + WO_UQ), QLP, WK_UQ, (const float*)a->in[11] + l * QL, 0};
    d[2] = WDesc{(const float*)a->in[14] + (size_t)l * KVL * NKVB, KVL, NKVB, (bf16*)(wb + WO_UKV), KVL, WK_UKV, (const float*)a->in[13] + l * KVL, 0};
    d[3] = WDesc{(const float*)a->in[17] + (size_t)l * DM * DM, DM, DM, (bf16*)(wb + WO_OUT), DM, WK_OUT, nullptr, 0};
    d[4] = WDesc{(const float*)a->in[18] + (size_t)l * DM * DFF, DM, DFF, (bf16*)(wb + WO_GU), DM, WK_GATE, nullptr, 0};
    d[5] = WDesc{(const float*)a->in[19] + (size_t)l * DM * DFF, DM, DFF, (bf16*)(wb + WO_GU), DM, WK_UP, nullptr, 0};
    d[6] = WDesc{(const float*)a->in[20] + (size_t)l * DFF * DM, DFF, DM, (bf16*)(wb + WO_DN), DFF, WK_DN, nullptr, 0};
#pragma unroll
    for (int i = 0; i < 7; ++i) d[i].nitems = (d[i].K / 64) * ((d[i].N + 31) / 32);
}
constexpr int WITEMS_EARLY = 32 * 133 + 7 * 24 + 2 * 32;
constexpr int WITEMS_LATE = 32 * 64 + 2 * 32 * 176 + 88 * 64;
__device__ __forceinline__ void convert_items(KArgs a, int l, int dlo, int dhi, int i0, int i1, int step, LAS float* scr, int lane) {
    WDesc d[7]; wdesc_layer(a, l, d);
    for (int it = i0; it < i1; it += step) {
        int r = it;
#pragma unroll
        for (int i = 0; i < 7; ++i) if (i >= dlo && i < dhi) { if (r >= 0 && r < d[i].nitems) transpose_item(d[i].W, d[i].K, d[i].N, d[i].WT, d[i].ldt, d[i].kind, d[i].rowg, scr, r, lane); r -= d[i].nitems; }
    }
}
constexpr int NDEF_ITEMS = WITEMS_LATE + WITEMS_EARLY + WITEMS_LATE, DEF_CHUNK = 64, NDEF_CHUNKS = (NDEF_ITEMS + DEF_CHUNK - 1) / DEF_CHUNK;
__device__ __forceinline__ void convert_deferred_chunk(KArgs a, LAS unsigned char* lds, int chunk, int wave, int lane) {
    LAS float* scr = (LAS float*)(lds + RING_OFF + wave * 16384);
    const int i0 = chunk * DEF_CHUNK, i1 = (i0 + DEF_CHUNK < NDEF_ITEMS) ? i0 + DEF_CHUNK : NDEF_ITEMS;
    { const int lo = i0, hi = i1 < WITEMS_LATE ? i1 : WITEMS_LATE; if (lo < hi) convert_items(a, 0, 3, 7, lo + wave, hi, NWAVES, scr, lane); }
    { const int lo = (i0 > WITEMS_LATE ? i0 : WITEMS_LATE) - WITEMS_LATE, hi = (i1 < WITEMS_LATE + WITEMS_EARLY ? i1 : WITEMS_LATE + WITEMS_EARLY) - WITEMS_LATE; if (lo < hi) convert_items(a, 1, 0, 3, lo + wave, hi, NWAVES, scr, lane); }
    { const int lo = (i0 > WITEMS_LATE + WITEMS_EARLY ? i0 : WITEMS_LATE + WITEMS_EARLY) - (WITEMS_LATE + WITEMS_EARLY), hi = i1 - (WITEMS_LATE + WITEMS_EARLY); if (lo < hi) convert_items(a, 1, 3, 7, lo + wave, hi, NWAVES, scr, lane); }
}

template <int PARTS> __device__ __forceinline__ void p0_prologue(KArgs a, LAS unsigned char* lds, int wave, int lane, int tid) {
    const int G = gridDim.x, gw = blockIdx.x * NWAVES + wave, NGW = G * NWAVES;
    LAS float* scr = (LAS float*)(lds + RING_OFF + wave * 16384);
    if (PARTS & 1) {
        convert_items(a, 0, 0, 7, gw, WITEMS_EARLY + WITEMS_LATE, NGW, scr, lane);
        convert_items(a, 1, 0, 7, gw, WITEMS_EARLY + WITEMS_LATE, NGW, scr, lane);
        for (int l = 0; l < DEPTH; ++l) { unsigned char* wb = a->ws + WS_W + (size_t)l * W_LAYER;
          bf16* wt = (bf16*)(wb + WO_IN); const int n16 = (NINP - 4256) * DM / 8;
          for (int i = blockIdx.x * NTHR + tid; i < n16; i += G * NTHR) *(GAS v4u*)(wt + (size_t)4256 * DM + (size_t)i * 8) = (v4u){0u, 0u, 0u, 0u};
          bf16* wq = (bf16*)(wb + WO_UQ); const int q16 = NQB * (QLP - QL) / 8;
          for (int i = blockIdx.x * NTHR + tid; i < q16; i += G * NTHR) { const int rr = i / ((QLP - QL) / 8), cc = i % ((QLP - QL) / 8); *(GAS v4u*)(wq + (size_t)rr * QLP + QL + cc * 8) = (v4u){0u, 0u, 0u, 0u}; } }
    }
    if (PARTS & 2) { const int* pos = (const int*)a->in[2]; float* cs = (float*)(a->ws + WS_COS); float* sn = (float*)(a->ws + WS_SIN);
      for (int i = blockIdx.x * NTHR + tid; i < M * 32; i += G * NTHR) { const int m = i >> 5, k = i & 31; const double ang = (double)pos[m] * INVF[k] * 0.15915494309189533577; const double r = ang - __builtin_floor(ang);
          float s, c; sincos_rev(r, s, c); cs[i] = c; sn[i] = s; } }
    __syncthreads();
    if (PARTS & 4) { LAS float* sc = (LAS float*)(lds + RING_OFF);
      LAS float* red = (LAS float*)(lds + RING_OFF + 65536);
      const float* cin = (const float*)a->in[1];
      for (int i = tid; i < BATCH * DM; i += NTHR) { const float x = cin[i]; sc[i] = x / (1.0f + __expf(-x)); }
      __syncthreads();
      const float* mw = (const float*)a->in[3]; const float* mb = (const float*)a->in[4]; float* mod = (float*)(a->ws + WS_MOD);
      for (int cg = blockIdx.x; cg < 256; cg += G) {
          const int l = cg / 128, n0 = (cg % 128) * 96;
          if (tid < 480) { const int c4 = tid % 24, ks = tid / 24; const float* wp = mw + (size_t)l * DM * NMOD + n0 + 4 * c4; f32x4 acc[8];
#pragma unroll
              for (int b = 0; b < 8; ++b) acc[b] = (f32x4){0.f, 0.f, 0.f, 0.f};
#pragma unroll 4
              for (int k = ks; k < DM; k += 20) { const f32x4 w = *(const GAS f32x4*)(wp + (size_t)k * NMOD);
#pragma unroll
                  for (int b = 0; b < 8; ++b) acc[b] += w * sc[b * DM + k]; }
#pragma unroll
              for (int b = 0; b < 8; ++b) *(LAS f32x4*)(red + (ks * 8 + b) * 96 + 4 * c4) = acc[b]; }
          __syncthreads();
          for (int i = tid; i < 768; i += NTHR) { const int b = i / 96, cc = i % 96; float s = 0.f;
#pragma unroll
              for (int ks = 0; ks < 20; ++ks) s += red[(ks * 8 + b) * 96 + cc];
              mod[((size_t)l * BATCH + b) * NMOD + n0 + cc] = s + mb[(size_t)l * NMOD + n0 + cc]; }
          __syncthreads();
      }
    }
}

__device__ __forceinline__ void prep_rows(KArgs a, int wave, int lane) {
    const bf16* proj = (const bf16*)(a->ws + WS_PROJ); float* rsq = (float*)(a->ws + WS_RSQ); float* rskv = (float*)(a->ws + WS_RSKV); bf16* kr = (bf16*)(a->ws + WS_KROPE);
    const float* cs = (const float*)(a->ws + WS_COS); const float* sn = (const float*)(a->ws + WS_SIN);
    const int gw = blockIdx.x * NWAVES + wave, NGW = gridDim.x * NWAVES;
    for (int m0 = gw * 4; m0 < M; m0 += NGW * 4) {
        v4u wq[4], wk[4]; unsigned short x1[4], x2[4]; float cc[4], ss[4];
#pragma unroll
        for (int j = 0; j < 4; ++j) { const bf16* p = proj + (size_t)(m0 + j) * NINP; wq[j] = (v4u){0u, 0u, 0u, 0u}; wk[j] = (v4u){0u, 0u, 0u, 0u};
            if (lane < 56) wq[j] = *(const GAS v4u*)(p + C_BCQ + lane * 8);
            if (lane < 16) wk[j] = *(const GAS v4u*)(p + C_BCKV + lane * 8);
            x1[j] = p[C_BKR + (lane & 31)]; x2[j] = p[C_BKR + 32 + (lane & 31)]; cc[j] = cs[(size_t)(m0 + j) * 32 + (lane & 31)]; ss[j] = sn[(size_t)(m0 + j) * 32 + (lane & 31)]; }
#pragma unroll
        for (int j = 0; j < 4; ++j) { float s1 = 0.f, s2 = 0.f;
#pragma unroll
            for (int e = 0; e < 4; ++e) { const float x = bflo(wq[j][e]), y = bfhi(wq[j][e]); s1 += x * x + y * y; const float u = bflo(wk[j][e]), v = bfhi(wk[j][e]); s2 += u * u + v * v; }
            s1 = wave_sum(s1); s2 = wave_sum(s2);
            if (lane == 0) { rsq[m0 + j] = 1.0f / sqrtf(s1 * (1.0f / QL) + EPS); rskv[m0 + j] = 1.0f / sqrtf(s2 * (1.0f / KVL) + EPS); }
            if (lane < 32) { const float a1 = bf2f(x1[j]), a2 = bf2f(x2[j]); *(GAS unsigned*)(kr + (size_t)(m0 + j) * 64 + 2 * lane) = pk2(a1 * cc[j] - a2 * ss[j], a1 * ss[j] + a2 * cc[j]); } }
    }
}

__device__ __forceinline__ void ld8(const bf16* p, float* o) { const v4u w = *(const GAS v4u*)p;
#pragma unroll
    for (int j = 0; j < 4; ++j) { o[2 * j] = bflo(w[j]); o[2 * j + 1] = bfhi(w[j]); } }

__device__ __forceinline__ void naive_window(KArgs a, int l, int tid) {
    const bf16* proj = (const bf16*)(a->ws + WS_PROJ); bf16* ycat = (bf16*)(a->ws + WS_YCAT); const float* sink = (const float*)a->in[10] + l * 12;
    const int gt = blockIdx.x * NTHR + tid, NT = gridDim.x * NTHR;
    for (int it = gt; it < M * 12; it += NT) {
        const int m = it / 12, hq = it % 12, b = m / SEQ, t = m % SEQ, kvh = hq / 3;
        float q[64], acc[64];
#pragma unroll
        for (int j = 0; j < 8; ++j) ld8(proj + (size_t)m * NINP + C_AQ + hq * 64 + 8 * j, q + 8 * j);
#pragma unroll
        for (int d = 0; d < 64; ++d) acc[d] = 0.f;
        float mr = sink[hq] * LOG2E, lr = 1.0f; const float slope = ALIBI[hq] * LOG2E;
        const int s0 = t - 128 < 0 ? 0 : t - 128, s1 = t + 128 > SEQ - 1 ? SEQ - 1 : t + 128;
        for (int s = s0; s <= s1; ++s) {
            const bf16* kp = proj + (size_t)(b * SEQ + s) * NINP + C_AK + kvh * 64; const bf16* vp = proj + (size_t)(b * SEQ + s) * NINP + C_AV + kvh * 64;
            float dot = 0.f;
#pragma unroll
            for (int j = 0; j < 8; ++j) { float k8[8]; ld8(kp + 8 * j, k8);
#pragma unroll
                for (int e = 0; e < 8; ++e) dot += q[8 * j + e] * k8[e]; }
            const int dist = t > s ? t - s : s - t; const float sc = dot - slope * (float)dist;
            const float mn = fmaxf(mr, sc), corr = __builtin_amdgcn_exp2f(mr - mn), p = __builtin_amdgcn_exp2f(sc - mn); lr = lr * corr + p; mr = mn;
#pragma unroll
            for (int j = 0; j < 8; ++j) { float v8[8]; ld8(vp + 8 * j, v8);
#pragma unroll
                for (int e = 0; e < 8; ++e) acc[8 * j + e] = acc[8 * j + e] * corr + p * v8[e]; }
        }
        const float inv = 1.0f / lr; bf16* op = ycat + (size_t)m * DM + hq * 64;
#pragma unroll
        for (int j = 0; j < 8; ++j) { v4u w; w.x = pk2(acc[8 * j] * inv, acc[8 * j + 1] * inv); w.y = pk2(acc[8 * j + 2] * inv, acc[8 * j + 3] * inv); w.z = pk2(acc[8 * j + 4] * inv, acc[8 * j + 5] * inv); w.w = pk2(acc[8 * j + 6] * inv, acc[8 * j + 7] * inv); *(GAS v4u*)(op + 8 * j) = w; }
    }
}
__device__ __forceinline__ void naive_mla(KArgs a, int tid) {
    const bf16* qm = (const bf16*)(a->ws + WS_QMLA); const bf16* kv = (const bf16*)(a->ws + WS_KVMLA); const bf16* kr = (const bf16*)(a->ws + WS_KROPE); bf16* ycat = (bf16*)(a->ws + WS_YCAT);
    const int gt = blockIdx.x * NTHR + tid, NT = gridDim.x * NTHR, g = gt & 3;
    for (int it = gt >> 2; it < M * 4; it += NT >> 2) {
        const int m = it >> 2, h = it & 3, b = m / SEQ;
        float q[48], acc[32];
#pragma unroll
        for (int j = 0; j < 4; ++j) ld8(qm + (size_t)m * NQB + h * 192 + 32 * g + 8 * j, q + 8 * j);
#pragma unroll
        for (int j = 0; j < 2; ++j) ld8(qm + (size_t)m * NQB + h * 192 + 128 + 16 * g + 8 * j, q + 32 + 8 * j);
#pragma unroll
        for (int d = 0; d < 32; ++d) acc[d] = 0.f;
        float mr = -INFINITY, lr = 0.f;
        for (int s = 0; s < SEQ; ++s) {
            const size_t row = (size_t)b * SEQ + s; const bf16* kp = kv + row * NKVB + h * 256 + 32 * g; const bf16* rp = kr + row * 64 + 16 * g; const bf16* vp = kv + row * NKVB + h * 256 + 128 + 32 * g;
            float dot = 0.f;
#pragma unroll
            for (int j = 0; j < 4; ++j) { float k8[8]; ld8(kp + 8 * j, k8);
#pragma unroll
                for (int e = 0; e < 8; ++e) dot += q[8 * j + e] * k8[e]; }
#pragma unroll
            for (int j = 0; j < 2; ++j) { float k8[8]; ld8(rp + 8 * j, k8);
#pragma unroll
                for (int e = 0; e < 8; ++e) dot += q[32 + 8 * j + e] * k8[e]; }
            dot += __shfl_xor(dot, 1); dot += __shfl_xor(dot, 2);
            const float mn = fmaxf(mr, dot), corr = __builtin_amdgcn_exp2f(mr - mn), p = __builtin_amdgcn_exp2f(dot - mn); lr = lr * corr + p; mr = mn;
#pragma unroll
            for (int j = 0; j < 4; ++j) { float v8[8]; ld8(vp + 8 * j, v8);
#pragma unroll
                for (int e = 0; e < 8; ++e) acc[8 * j + e] = acc[8 * j + e] * corr + p * v8[e]; }
        }
        const float inv = 1.0f / lr; bf16* op = ycat + (size_t)m * DM + 768 + h * 128 + 32 * g;
#pragma unroll
        for (int j = 0; j < 4; ++j) { v4u w; w.x = pk2(acc[8 * j] * inv, acc[8 * j + 1] * inv); w.y = pk2(acc[8 * j + 2] * inv, acc[8 * j + 3] * inv); w.z = pk2(acc[8 * j + 4] * inv, acc[8 * j + 5] * inv); w.w = pk2(acc[8 * j + 6] * inv, acc[8 * j + 7] * inv); *(GAS v4u*)(op + 8 * j) = w; }
    }
}
__device__ __forceinline__ void naive_mlstm(KArgs a, int l, LAS unsigned char* lds, int tid) {
    const bf16* proj = (const bf16*)(a->ws + WS_PROJ); float* hf = (float*)a->out; const float* gb = (const float*)a->in[15] + l * 16;
    LAS float* den_s = (LAS float*)(lds + RING_OFF); LAS float* mt_s = den_s + SEQ;
    for (int job = blockIdx.x; job < 64; job += gridDim.x) {
        const int dir = job & 1, bh = job >> 1, b = bh >> 2, h = bh & 3; const int e = tid;
        float* hd = hf + (size_t)dir * M * 768;
        if (e <= 192) {
            float C[96];
#pragma unroll
            for (int d = 0; d < 96; ++d) C[d] = 0.f;
            float mrun = -INFINITY;
            const float bi = gb[(dir ? 1 : 0) * 4 + h], bfg = gb[(dir ? 3 : 2) * 4 + h];
            for (int tt = 0; tt < SEQ; ++tt) {
                const int t = dir ? SEQ - 1 - tt : tt; const bf16* p = proj + (size_t)(b * SEQ + t) * NINP;
                const float li = bf2f(p[C_CG + (dir ? 1 : 0) * 4 + h]) + bi, fp = bf2f(p[C_CG + (dir ? 3 : 2) * 4 + h]) + bfg;
                const float lf = fminf(fp, 0.f) - log1pf(__expf(-fabsf(fp)));
                const float mn = fmaxf(lf + mrun, li), fa = __expf(lf + mrun - mn), fb = __expf(li - mn); mrun = mn;
                const float v = (e < 192) ? bf2f(p[C_CV + h * 192 + e]) : 1.0f; const float bv = fb * v;
                float num = 0.f;
#pragma unroll
                for (int j = 0; j < 12; ++j) { float q8[8], k8[8]; ld8(p + C_CQ + h * 96 + 8 * j, q8); ld8(p + C_CK + h * 96 + 8 * j, k8);
#pragma unroll
                    for (int d = 0; d < 8; ++d) { C[8 * j + d] = fa * C[8 * j + d] + bv * k8[d]; num += q8[d] * C[8 * j + d]; } }
                if (e < 192) hd[(size_t)(b * SEQ + t) * 768 + h * 192 + e] = num; else { den_s[t] = num; mt_s[t] = mn; }
            }
        }
        __syncthreads();
        if (e < 192) { for (int t = 0; t < SEQ; ++t) { float* q = hd + (size_t)(b * SEQ + t) * 768 + h * 192 + e; *q = *q / fmaxf(fabsf(den_s[t]), __expf(-mt_s[t])); } }
        __syncthreads();
    }
}
typedef float f32x2c __attribute__((ext_vector_type(2)));
struct CombRegs { unsigned wf[12], wb[12]; bf16 op[2][12]; f32x2c df[4], db[4]; };
__device__ __forceinline__ void comb_load(CombRegs& R, const unsigned* hf, const bf16* proj, const float* dnp, int m0, int lane) {
    int mm = m0 < M ? m0 : M - 2; const int b = mm / SEQ, t0 = mm % SEQ, u0 = SEQ - 2 - t0; const int r = lane & 31, wl = lane >> 5;
    const int cf = t0 >> 6, lf = t0 & 63, cbk = u0 >> 6, lb = u0 & 63;
    const unsigned of = (unsigned)(((lf >> 5) * 8 + ((((lf & 31) >> 3) << 1) | ((lf >> 1) & 1))) * 64 + ((lf >> 2) & 1) * 32 + r), ob = (unsigned)(((lb >> 5) * 8 + ((((lb & 31) >> 3) << 1) | ((lb >> 1) & 1))) * 64 + ((lb >> 2) & 1) * 32 + r);
#pragma unroll
    for (int h = 0; h < 4; ++h) { R.df[h] = *(const GAS f32x2c*)(dnp + ((size_t)(0 * BATCH + b) * 4 + h) * SEQ + t0); R.db[h] = *(const GAS f32x2c*)(dnp + ((size_t)(1 * BATCH + b) * 4 + h) * SEQ + u0);
#pragma unroll
        for (int k = 0; k < 3; ++k) { const int w = 2 * k + wl;
            R.wf[3 * h + k] = hf[((((size_t)(0 * BATCH + b) * 4 + h) * 64 + cf) * 6 + w) * 1024 + of];
            R.wb[3 * h + k] = hf[((((size_t)(1 * BATCH + b) * 4 + h) * 64 + cbk) * 6 + w) * 1024 + ob]; } }
#pragma unroll
    for (int j = 0; j < 2; ++j)
#pragma unroll
        for (int i = 0; i < 12; ++i) R.op[j][i] = proj[(size_t)(mm + j) * NINP + C_CO + 64 * i + lane];
}
__device__ __forceinline__ void comb_compute(const CombRegs& R, const float (&g)[12], bf16* ycat, int m0, int lane) {
#pragma unroll
    for (int j = 0; j < 2; ++j) { const size_t m = (size_t)(m0 + j);
#pragma unroll
        for (int h = 0; h < 4; ++h) { const float d0 = 1.0f / R.df[h][j], d1 = 1.0f / R.db[h][1 - j]; float x[3]; float ss = 0.f;
#pragma unroll
            for (int i = 0; i < 3; ++i) { const float vf = j == 0 ? bflo(R.wf[3 * h + i]) : bfhi(R.wf[3 * h + i]), vb = j == 0 ? bfhi(R.wb[3 * h + i]) : bflo(R.wb[3 * h + i]);
                x[i] = vf * d0 + vb * d1; ss += x[i] * x[i]; }
            const float rstd = 1.0f / sqrtf(wave_sum(ss) * (1.0f / 192) + EPS);
#pragma unroll
            for (int i = 0; i < 3; ++i) { const int c = h * 192 + 64 * i + lane; const float sg = 1.0f / (1.0f + __expf(-bf2f(R.op[j][3 * h + i])));
                ycat[m * DM + 1280 + c] = (bf16)f2bf(sg * x[i] * rstd * g[3 * h + i]); } } }
}
__device__ __forceinline__ void mlstm_combine(KArgs a, int l, int wave, int lane) {
    const bf16* proj = (const bf16*)(a->ws + WS_PROJ); const unsigned* hf = (const unsigned*)a->out; bf16* ycat = (bf16*)(a->ws + WS_YCAT);
    const float* hg = (const float*)a->in[16] + l * 768; const float* dnp = (const float*)(a->ws + WS_GPREP);
    const int gw = blockIdx.x * NWAVES + wave, NGW = gridDim.x * NWAVES;
    float g[12];
#pragma unroll
    for (int i = 0; i < 12; ++i) g[i] = hg[64 * i + lane];
    const int st = NGW * 2; int m0 = gw * 2;
    CombRegs A, B;
    comb_load(A, hf, proj, dnp, m0, lane);
#pragma unroll 1
    while (m0 < M) {
        comb_load(B, hf, proj, dnp, m0 + st, lane);
        comb_compute(A, g, ycat, m0, lane);
        m0 += st; if (m0 >= M) break;
        comb_load(A, hf, proj, dnp, m0 + st, lane);
        comb_compute(B, g, ycat, m0, lane);
        m0 += st;
    }
}

typedef float f32x16 __attribute__((ext_vector_type(16)));
typedef short v4i16_t __attribute__((ext_vector_type(4)));
typedef float f32x2_t __attribute__((ext_vector_type(2))); typedef __bf16 bf16x2_t __attribute__((ext_vector_type(2)));
__device__ __forceinline__ unsigned cvtpk(float lo, float hi) { f32x2_t v = {lo, hi}; bf16x2_t b = __builtin_convertvector(v, bf16x2_t); return __builtin_bit_cast(unsigned, b); }
__device__ __forceinline__ v4i16_t vtr(LAS unsigned char* p) { return __builtin_amdgcn_ds_read_tr16_b64_v4i16((LAS v4i16_t*)p); }
__device__ __forceinline__ bf16x8 mk8(v4i16_t lo, v4i16_t hi) { return (bf16x8){lo[0], lo[1], lo[2], lo[3], hi[0], hi[1], hi[2], hi[3]}; }
__device__ __forceinline__ bf16x8 pack8(const f32x16& p, int s) {
    v4u w; w.x = cvtpk(p[8 * s + 0], p[8 * s + 1]); w.y = cvtpk(p[8 * s + 2], p[8 * s + 3]); w.z = cvtpk(p[8 * s + 4], p[8 * s + 5]); w.w = cvtpk(p[8 * s + 6], p[8 * s + 7]);
    return __builtin_bit_cast(bf16x8, w);
}
__device__ __forceinline__ float max16(const f32x16& p) {
    float a = fmaxf(fmaxf(p[0], p[1]), fmaxf(p[2], p[3])), b = fmaxf(fmaxf(p[4], p[5]), fmaxf(p[6], p[7])), c = fmaxf(fmaxf(p[8], p[9]), fmaxf(p[10], p[11])), d = fmaxf(fmaxf(p[12], p[13]), fmaxf(p[14], p[15]));
    return fmaxf(fmaxf(a, b), fmaxf(c, d));
}
__device__ __forceinline__ float sum16(const f32x16& p) {
    return (((p[0] + p[1]) + (p[2] + p[3])) + ((p[4] + p[5]) + (p[6] + p[7]))) + (((p[8] + p[9]) + (p[10] + p[11])) + ((p[12] + p[13]) + (p[14] + p[15])));
}

constexpr int MLA_KN = 0, MLA_KR = 16384, MLA_V = 24576, MLA_BUF = 40960;
static_assert(2 * MLA_BUF <= RING_BYTES, "MLA LDS");
__device__ __forceinline__ void mla_dma(const bf16* kvb  , const bf16* krb  , LAS unsigned char* buf, int wave, unsigned okn0, unsigned okn1, unsigned okr, unsigned ov0, unsigned ov1) {
    const GAS char* kb = (const GAS char*)kvb; const GAS char* rb = (const GAS char*)krb;
    __builtin_amdgcn_global_load_lds((const GAS unsigned*)(kb + okn0), (LAS unsigned*)(buf + MLA_KN + wave * 2048), 16, 0, 0);
    __builtin_amdgcn_global_load_lds((const GAS unsigned*)(kb + okn1), (LAS unsigned*)(buf + MLA_KN + wave * 2048 + 1024), 16, 0, 0);
    __builtin_amdgcn_global_load_lds((const GAS unsigned*)(rb + okr), (LAS unsigned*)(buf + MLA_KR + wave * 1024), 16, 0, 0);
    __builtin_amdgcn_global_load_lds((const GAS unsigned*)(kb + ov0), (LAS unsigned*)(buf + MLA_V + wave * 2048), 16, 0, 0);
    __builtin_amdgcn_global_load_lds((const GAS unsigned*)(kb + ov1), (LAS unsigned*)(buf + MLA_V + wave * 2048 + 1024), 16, 0, 0);
}
__device__ __forceinline__ void mla_unit(const bf16* qm, const bf16* kv, const bf16* kr, bf16* ycat, LAS unsigned char* lds, int b, int h, int qb, int wave, int ln) {
    const int r = ln & 31, hh = ln >> 5;
    const size_t row0 = (size_t)b * SEQ; const int q0 = qb * 256 + wave * 32;
    unsigned okn0, okn1, okr, ov0, ov1;
    { const int rA = 8 * wave + (ln >> 4), rB = rA + 4, pc = ln & 15;
      okn0 = (unsigned)(rA * NKVB * 2 + ((pc ^ (rA & 15)) * 16)); okn1 = (unsigned)(rB * NKVB * 2 + ((pc ^ (rB & 15)) * 16));
      const int rr = 8 * wave + (ln >> 3), pr = ln & 7; okr = (unsigned)(rr * 128 + ((pr ^ ((rr >> 1) & 7)) * 16));
      ov0 = (unsigned)(rA * NKVB * 2 + 256 + (((((pc >> 2) ^ (rA & 3)) << 2) | (pc & 3)) * 16)); ov1 = (unsigned)(rB * NKVB * 2 + 256 + (((((pc >> 2) ^ (rB & 3)) << 2) | (pc & 3)) * 16)); }
    const bf16* kvb = kv + row0 * NKVB + h * 256; const bf16* krb = kr + row0 * 64;
    mla_dma(kvb, krb, lds, wave, okn0, okn1, okr, ov0, ov1);
    bf16x8 qf[12];
    { const bf16* qp = qm + (row0 + q0 + r) * NQB + h * 192 + 8 * hh;
#pragma unroll
      for (int d0 = 0; d0 < 12; ++d0) qf[d0] = *(const GAS bf16x8*)(qp + 16 * d0); }
    f32x16 o[4];
#pragma unroll
    for (int db = 0; db < 4; ++db)
#pragma unroll
        for (int i = 0; i < 16; ++i) o[db][i] = 0.f;
    float mrun = 0.f, lrun = 0.f;
    const int q4 = (ln & 15) >> 2;
    const int kn_base = MLA_KN + r * 256 + (((r & 15) ^ hh) * 16), kr_base = MLA_KR + r * 128 + ((((r >> 1) & 7) ^ hh) * 16);
    const int v_base = MLA_V + (4 * hh + q4) * 256 + q4 * 64 + (((ln >> 4) & 1) * 16 + (ln & 3) * 4) * 2;
    for (int kt = 0; kt < SEQ / 64; ++kt) {
        __syncthreads();
        LAS unsigned char* buf = lds + (kt & 1) * MLA_BUF;
        if (kt + 1 < SEQ / 64) mla_dma(kvb + (size_t)(kt + 1) * 64 * NKVB, krb + (size_t)(kt + 1) * 64 * 64, lds + ((kt + 1) & 1) * MLA_BUF, wave, okn0, okn1, okr, ov0, ov1);
        f32x16 s0, s1;
        { const float negm = -mrun;
#pragma unroll
          for (int i = 0; i < 16; ++i) { s0[i] = negm; s1[i] = negm; } }
        {
            bf16x8 ka[2][2];
#define MLA_KLD(dst, d0_) do { if ((d0_) < 8) { LAS unsigned char* kp_ = buf + (kn_base ^ ((d0_) * 32)); dst[0] = *(LAS bf16x8*)kp_; dst[1] = *(LAS bf16x8*)(kp_ + 32 * 256); } \
                               else { LAS unsigned char* kp_ = buf + (kr_base ^ (((d0_) - 8) * 32)); dst[0] = *(LAS bf16x8*)kp_; dst[1] = *(LAS bf16x8*)(kp_ + 32 * 128); } } while (0)
            MLA_KLD(ka[0], 0);
#pragma unroll
            for (int d0 = 0; d0 < 12; ++d0) {
                if (d0 + 1 < 12) MLA_KLD(ka[(d0 + 1) & 1], d0 + 1);
                s0 = __builtin_amdgcn_mfma_f32_32x32x16_bf16(ka[d0 & 1][0], qf[d0], s0, 0, 0, 0); s1 = __builtin_amdgcn_mfma_f32_32x32x16_bf16(ka[d0 & 1][1], qf[d0], s1, 0, 0, 0);
            }
#undef MLA_KLD
        }
        float mx = fmaxf(max16(s0), max16(s1)); mx = fmaxf(mx, __shfl_xor(mx, 32));
        if (__builtin_expect(__any(mx > 6.0f) || kt == 0, 0)) {
            const float delta = (kt == 0) ? mx : fmaxf(mx, 0.f), alpha = __builtin_amdgcn_exp2f(-delta); mrun += delta; lrun *= alpha;
#pragma unroll
            for (int i = 0; i < 16; ++i) { s0[i] -= delta; s1[i] -= delta; }
#pragma unroll
            for (int db = 0; db < 4; ++db)
#pragma unroll
                for (int i = 0; i < 16; ++i) o[db][i] *= alpha;
        }
#pragma unroll
        for (int i = 0; i < 16; ++i) { s0[i] = __builtin_amdgcn_exp2f(s0[i]); s1[i] = __builtin_amdgcn_exp2f(s1[i]); }
        lrun += sum16(s0) + sum16(s1);
        const bf16x8 p00 = pack8(s0, 0), p01 = pack8(s0, 1), p10 = pack8(s1, 0), p11 = pack8(s1, 1);
        {
            bf16x8 va[2][4];
#define MLA_VLD(dst, db_) do { LAS unsigned char* vb_ = buf + (v_base ^ ((db_) * 64)); dst[0] = mk8(vtr(vb_), vtr(vb_ + 8 * 256)); dst[1] = mk8(vtr(vb_ + 16 * 256), vtr(vb_ + 24 * 256)); \
                               dst[2] = mk8(vtr(vb_ + 32 * 256), vtr(vb_ + 40 * 256)); dst[3] = mk8(vtr(vb_ + 48 * 256), vtr(vb_ + 56 * 256)); } while (0)
            MLA_VLD(va[0], 0);
#pragma unroll
            for (int db = 0; db < 4; ++db) {
                if (db + 1 < 4) MLA_VLD(va[(db + 1) & 1], db + 1);
                o[db] = __builtin_amdgcn_mfma_f32_32x32x16_bf16(va[db & 1][0], p00, o[db], 0, 0, 0); o[db] = __builtin_amdgcn_mfma_f32_32x32x16_bf16(va[db & 1][1], p01, o[db], 0, 0, 0);
                o[db] = __builtin_amdgcn_mfma_f32_32x32x16_bf16(va[db & 1][2], p10, o[db], 0, 0, 0); o[db] = __builtin_amdgcn_mfma_f32_32x32x16_bf16(va[db & 1][3], p11, o[db], 0, 0, 0);
            }
#undef MLA_VLD
        }
    }
    lrun += __shfl_xor(lrun, 32);
    const float inv = 1.0f / lrun;
    bf16* op = ycat + (row0 + q0 + r) * DM + 768 + h * 128 + 4 * hh;
#pragma unroll
    for (int db = 0; db < 4; ++db)
#pragma unroll
        for (int g4 = 0; g4 < 4; ++g4) { v2u w; w.x = cvtpk(o[db][4 * g4] * inv, o[db][4 * g4 + 1] * inv); w.y = cvtpk(o[db][4 * g4 + 2] * inv, o[db][4 * g4 + 3] * inv); *(GAS v2u*)(op + 32 * db + 8 * g4) = w; }
}
__device__ __forceinline__ void mla_phase(KArgs a, LAS unsigned char* lds, int wave, int ln) {
    const bf16* qm = (const bf16*)(a->ws + WS_QMLA); const bf16* kv = (const bf16*)(a->ws + WS_KVMLA); const bf16* kr = (const bf16*)(a->ws + WS_KROPE); bf16* ycat = (bf16*)(a->ws + WS_YCAT);
    const int G = gridDim.x;
    const int xcd = blockIdx.x & 7, slot = blockIdx.x >> 3, per = (G + 7) >> 3;
    for (int v = slot; v < 64; v += per) { const int bh = xcd * 4 + (v >> 4), qb = v & 15; mla_unit(qm, kv, kr, ycat, lds, bh >> 2, bh & 3, qb, wave, ln); }
}

constexpr int WIN_K = 0, WIN_V = 65536;
static_assert(WIN_V + 512 * 128 <= RING_BYTES, "window LDS");
__device__ __forceinline__ void win_unit(const bf16* proj, bf16* ycat, float sinkv, float slope, LAS unsigned char* lds, int b, int hq, int qb, int wave, int ln) {
    const int r = ln & 31, hh = ln >> 5, kvh = hq / 3;
    const size_t row0 = (size_t)b * SEQ; const int q0 = qb * 256, ks0 = q0 - 128;
    __syncthreads();
    { const int pc = ln & 7;
#pragma unroll
      for (int j = 0; j < 8; ++j) { const int p = wave * 8 + j, row = 8 * p + (ln >> 3); int s = ks0 + row; s = s < 0 ? 0 : (s > SEQ - 1 ? SEQ - 1 : s);
          const bf16* src = proj + (row0 + s) * NINP + kvh * 64;
          const int ck = pc ^ ((row >> 1) & 7), cv = (((pc >> 2) ^ ((row >> 1) & 1)) << 2) | (pc & 3);
          __builtin_amdgcn_global_load_lds((const GAS unsigned*)(src + C_AK + ck * 8), (LAS unsigned*)(lds + WIN_K + p * 1024), 16, 0, 0);
          __builtin_amdgcn_global_load_lds((const GAS unsigned*)(src + C_AV + cv * 8), (LAS unsigned*)(lds + WIN_V + p * 1024), 16, 0, 0); } }
    const int tq = q0 + wave * 32 + r;
    bf16x8 qf[4];
    { const bf16* qp = proj + (row0 + tq) * NINP + C_AQ + hq * 64 + 8 * hh;
#pragma unroll
      for (int d0 = 0; d0 < 4; ++d0) qf[d0] = *(const GAS bf16x8*)(qp + 16 * d0); }
    f32x16 o[2];
#pragma unroll
    for (int db = 0; db < 2; ++db)
#pragma unroll
        for (int i = 0; i < 16; ++i) o[db][i] = 0.f;
    float mrun = sinkv, lrun = (hh == 0) ? 1.0f : 0.0f;
    const int kb0 = q0 + wave * 32 - 128;
    const int q4 = (ln & 15) >> 2;
    const int koff = WIN_K + (wave * 32 + r) * 128 + ((hh ^ ((r >> 1) & 7)) * 16);
    const int voff = WIN_V + (wave * 32 + 4 * hh + q4) * 128 + (((ln >> 4) & 1) * 16 + (ln & 3) * 4) * 2;
    const int vsw = ((q4 >> 1) & 1) * 64;
    const float fq = (float)(tq - kb0 - 4 * hh);
    __syncthreads();
#pragma unroll 1
    for (int kp = 0; kp < 5; ++kp) {
        const bool two = kp < 4;
        const int kbase = kb0 + 64 * kp;
        bf16x8 kf[4], kg[4];
#pragma unroll
        for (int d0 = 0; d0 < 4; ++d0) kf[d0] = *(LAS bf16x8*)(lds + kp * 8192 + (koff ^ (d0 * 32)));
        if (two) {
#pragma unroll
            for (int d0 = 0; d0 < 4; ++d0) kg[d0] = *(LAS bf16x8*)(lds + kp * 8192 + 4096 + (koff ^ (d0 * 32)));
        }
        f32x16 s0, s1;
#pragma unroll
        for (int i = 0; i < 16; ++i) { s0[i] = 0.f; s1[i] = two ? 0.f : -INFINITY; }
#pragma unroll
        for (int d0 = 0; d0 < 4; ++d0) s0 = __builtin_amdgcn_mfma_f32_32x32x16_bf16(kf[d0], qf[d0], s0, 0, 0, 0);
        if (two) {
#pragma unroll
            for (int d0 = 0; d0 < 4; ++d0) s1 = __builtin_amdgcn_mfma_f32_32x32x16_bf16(kg[d0], qf[d0], s1, 0, 0, 0);
        }
        if (kp == 0 || kp == 4 || kbase < 0 || kbase + 64 > SEQ) {
#pragma unroll
            for (int i = 0; i < 16; ++i) { const int key = kbase + (i & 3) + 8 * (i >> 2) + 4 * hh; const int dist = tq > key ? tq - key : key - tq;
                const bool ok = (key >= 0) && (key < SEQ) && (dist <= 128); s0[i] = ok ? s0[i] - slope * (float)dist : -INFINITY; }
            if (two) {
#pragma unroll
                for (int i = 0; i < 16; ++i) { const int key = kbase + 32 + (i & 3) + 8 * (i >> 2) + 4 * hh; const int dist = tq > key ? tq - key : key - tq;
                    const bool ok = (key >= 0) && (key < SEQ) && (dist <= 128); s1[i] = ok ? s1[i] - slope * (float)dist : -INFINITY; }
            }
        } else {
            const float fb = fq - 64.0f * (float)kp;
#pragma unroll
            for (int i = 0; i < 16; ++i) { const float c = (float)((i & 3) + 8 * (i >> 2)); s0[i] = __builtin_fmaf(-slope, __builtin_fabsf(fb - c), s0[i]); s1[i] = __builtin_fmaf(-slope, __builtin_fabsf(fb - 32.0f - c), s1[i]); }
        }
        float mx = fmaxf(max16(s0), max16(s1)); mx = fmaxf(mx, __shfl_xor(mx, 32));
        const float mnew = fmaxf(mrun, mx), alpha = __builtin_amdgcn_exp2f(mrun - mnew); mrun = mnew;
#pragma unroll
        for (int i = 0; i < 16; ++i) { s0[i] = __builtin_amdgcn_exp2f(s0[i] - mnew); s1[i] = __builtin_amdgcn_exp2f(s1[i] - mnew); }
        lrun = lrun * alpha + (sum16(s0) + sum16(s1));
#pragma unroll
        for (int db = 0; db < 2; ++db)
#pragma unroll
            for (int i = 0; i < 16; ++i) o[db][i] *= alpha;
        const bf16x8 p00 = pack8(s0, 0), p01 = pack8(s0, 1), p10 = pack8(s1, 0), p11 = pack8(s1, 1);
#pragma unroll
        for (int db = 0; db < 2; ++db) { LAS unsigned char* vb = lds + kp * 8192 + voff + ((db * 64) ^ vsw);
            const bf16x8 v0 = mk8(vtr(vb), vtr(vb + 8 * 128)), v1 = mk8(vtr(vb + 16 * 128), vtr(vb + 24 * 128));
            o[db] = __builtin_amdgcn_mfma_f32_32x32x16_bf16(v0, p00, o[db], 0, 0, 0); o[db] = __builtin_amdgcn_mfma_f32_32x32x16_bf16(v1, p01, o[db], 0, 0, 0); }
        if (two) {
#pragma unroll
            for (int db = 0; db < 2; ++db) { LAS unsigned char* vb = lds + kp * 8192 + 4096 + voff + ((db * 64) ^ vsw);
                const bf16x8 v0 = mk8(vtr(vb), vtr(vb + 8 * 128)), v1 = mk8(vtr(vb + 16 * 128), vtr(vb + 24 * 128));
                o[db] = __builtin_amdgcn_mfma_f32_32x32x16_bf16(v0, p10, o[db], 0, 0, 0); o[db] = __builtin_amdgcn_mfma_f32_32x32x16_bf16(v1, p11, o[db], 0, 0, 0); }
        }
    }
    lrun += __shfl_xor(lrun, 32);
    const float inv = 1.0f / lrun;
    bf16* op = ycat + (row0 + tq) * DM + hq * 64 + 4 * hh;
#pragma unroll
    for (int db = 0; db < 2; ++db)
#pragma unroll
        for (int g4 = 0; g4 < 4; ++g4) { v2u w; w.x = cvtpk(o[db][4 * g4] * inv, o[db][4 * g4 + 1] * inv); w.y = cvtpk(o[db][4 * g4 + 2] * inv, o[db][4 * g4 + 3] * inv); *(GAS v2u*)(op + 32 * db + 8 * g4) = w; }
}
__device__ __forceinline__ void win_phase(KArgs a, int l, LAS unsigned char* lds, int wave, int ln) {
    const bf16* proj = (const bf16*)(a->ws + WS_PROJ); bf16* ycat = (bf16*)(a->ws + WS_YCAT); const float* sink = (const float*)a->in[10] + l * 12;
    for (int u = blockIdx.x; u < BATCH * 12 * 16; u += gridDim.x) { const int qb = u & 15, hq = (u >> 4) % 12, b = u / 192;
        win_unit(proj, ycat, sink[hq] * LOG2E, ALIBI[hq] * LOG2E, lds, b, hq, qb, wave, ln); }
    __syncthreads();
}

constexpr int ML_U = 0, ML_MM = 16384, ML_BB = 32768, ML_MP = 49152, ML_IW = 49408, ML_T = 49664;
constexpr int ML_QP = 208, ML_KWP = 192, ML_VP = 448, ML_DP = 144;
constexpr int ML_Q = ML_T, ML_K = ML_Q + 64 * ML_QP, ML_KW = ML_K + 64 * ML_QP, ML_V = ML_KW + 64 * ML_KWP, ML_D = ML_V + 64 * ML_VP, ML_END = ML_D + 64 * ML_DP;
static_assert(ML_END <= RING_BYTES, "mLSTM LDS");
constexpr size_t WS_DN = WS_GPREP;
#define ML_BAR() asm volatile("s_waitcnt lgkmcnt(0)\n\ts_barrier" ::: "memory")
struct MlStage { v4u qk[3]; v4u v[3]; };
__device__ __forceinline__ void ml_load(MlStage& st, const bf16* base  , int h, int dir, int t) {
    const GAS char* bp = (const GAS char*)base;
#pragma unroll
    for (int k = 0; k < 3; ++k) { const int idx = t + 512 * k, which = idx / 768, rem = idx % 768, row = rem / 12, ch = rem % 12; const int pr = dir ? 63 - row : row;
        const unsigned off = (unsigned)(pr * NINP + (which ? C_CK : C_CQ) + h * 96 + ch * 8) * 2u; st.qk[k] = *(const GAS v4u*)(bp + off); }
#pragma unroll
    for (int k = 0; k < 3; ++k) { const int idx = t + 512 * k, row = idx / 24, ch = idx % 24; const int pr = dir ? 63 - row : row;
        const unsigned off = (unsigned)(pr * NINP + C_CV + h * 192 + ch * 8) * 2u; st.v[k] = *(const GAS v4u*)(bp + off); }
}
__device__ __forceinline__ void ml_store(const MlStage& st, LAS unsigned char* lds, int c, int t) {
    const float mlast = *(LAS float*)(lds + ML_MM + (c * 64 + 63) * 4);
#pragma unroll
    for (int k = 0; k < 3; ++k) { const int idx = t + 512 * k, which = idx / 768, rem = idx % 768, row = rem / 12, ch = rem % 12;
        if (which == 0) *(LAS v4u*)(lds + ML_Q + row * ML_QP + ch * 16) = st.qk[k];
        else { *(LAS v4u*)(lds + ML_K + row * ML_QP + ch * 16) = st.qk[k];
            const float sc = __expf(*(LAS float*)(lds + ML_U + (c * 64 + row) * 4) - mlast); v4u w;
#pragma unroll
            for (int j = 0; j < 4; ++j) w[j] = cvtpk(bflo(st.qk[k][j]) * sc, bfhi(st.qk[k][j]) * sc);
            *(LAS v4u*)(lds + ML_KW + row * ML_KWP + ch * 16) = w; } }
#pragma unroll
    for (int k = 0; k < 3; ++k) { const int idx = t + 512 * k, row = idx / 24, ch = idx % 24; *(LAS v4u*)(lds + ML_V + row * ML_VP + ch * 16) = st.v[k]; }
}
__device__ __forceinline__ void mlstm_job(KArgs a, int l, LAS unsigned char* lds, int job, int wave, int ln) {
    const bf16* proj = (const bf16*)(a->ws + WS_PROJ); float* hf = a->out; float* dn = (float*)(a->ws + WS_DN); const float* gb = (const float*)a->in[15] + l * 16;
    const int dir = job & 1, bh = job >> 1, b = bh >> 2, h = bh & 3, t = wave * 64 + ln, r = ln & 31, hh = ln >> 5;
    LAS float* U = (LAS float*)(lds + ML_U); LAS float* MM = (LAS float*)(lds + ML_MM); LAS float* BB = (LAS float*)(lds + ML_BB); LAS float* MP = (LAS float*)(lds + ML_MP); LAS float* IW = (LAS float*)(lds + ML_IW);
    __syncthreads();
    { const float bi = gb[(dir ? 1 : 0) * 4 + h], bfg = gb[(dir ? 3 : 2) * 4 + h];
      for (int k = 0; k < 8; ++k) { const int tp = t + 512 * k, tph = dir ? SEQ - 1 - tp : tp; const bf16* p = proj + (size_t)(b * SEQ + tph) * NINP + C_CG;
          const float li = bf2f(p[(dir ? 1 : 0) * 4 + h]) + bi, fp = bf2f(p[(dir ? 3 : 2) * 4 + h]) + bfg; U[tp] = li; BB[tp] = fminf(fp, 0.f) - log1pf(__expf(-fabsf(fp))); } }
    __syncthreads();
    if (wave == 0) {
        float bsum = 0.f, pm = -INFINITY;
        for (int i = 0; i < 64; ++i) { const int idx = ln * 64 + i; bsum += BB[idx]; const float u = U[idx] - bsum; pm = fmaxf(pm, u); BB[idx] = bsum; U[idx] = u; MM[idx] = pm; }
        float mp = -INFINITY;
        for (int c = 0; c < 64; ++c) { if (ln == c) MP[c] = mp; const float bl = __shfl(bsum, c), pl = __shfl(pm, c); mp = bl + fmaxf(mp, pl); }
    }
    __syncthreads();
    for (int k = 0; k < 8; ++k) { const int tp = t + 512 * k; MM[tp] = fmaxf(MP[tp >> 6], MM[tp]); }
    __syncthreads();
    MlStage st;
    const bf16* rowbase = proj + (size_t)(b * SEQ) * NINP;
    ml_load(st, rowbase + (size_t)(dir ? SEQ - 64 : 0) * NINP, h, dir, t); ml_store(st, lds, 0, t);
    f32x16 Cacc[3];
#pragma unroll
    for (int kb = 0; kb < 3; ++kb)
#pragma unroll
        for (int i = 0; i < 16; ++i) Cacc[kb][i] = 0.f;
    const bool is_den = (wave == 6);
    const int trow = (4 * hh + ((ln & 15) >> 2)), tcol = (((ln >> 4) & 1) * 16 + (ln & 3) * 4) * 2;
    const bf16x8 ones = (bf16x8){0x3F80, 0x3F80, 0x3F80, 0x3F80, 0x3F80, 0x3F80, 0x3F80, 0x3F80};
    __syncthreads();
    for (int c = 0; c < 64; ++c) {
        if (c + 1 < 64) ml_load(st, rowbase + (size_t)(dir ? SEQ - 64 - (c + 1) * 64 : (c + 1) * 64) * NINP, h, dir, t);
        const float mprev = MP[c], mlast = MM[c * 64 + 63];
        if (wave < 4) {
            const int sblk = wave >> 1, lblk = wave & 1;
            LAS unsigned char* dp = lds + ML_D + (32 * lblk + r) * ML_DP + (sblk * 4 + hh) * 16;
            if (sblk > lblk) { *(LAS v4u*)dp = (v4u){0u, 0u, 0u, 0u}; *(LAS v4u*)(dp + 32) = (v4u){0u, 0u, 0u, 0u}; }
            else {
                bf16x8 kf[6], qf[6];
#pragma unroll
                for (int d0 = 0; d0 < 6; ++d0) { kf[d0] = *(LAS bf16x8*)(lds + ML_K + (32 * sblk + r) * ML_QP + d0 * 32 + hh * 16); qf[d0] = *(LAS bf16x8*)(lds + ML_Q + (32 * lblk + r) * ML_QP + d0 * 32 + hh * 16); }
                const int lq = 32 * lblk + r; const float Ml = MM[c * 64 + lq];
                f32x4 us[4];
#pragma unroll
                for (int i4 = 0; i4 < 4; ++i4) us[i4] = *(LAS f32x4*)(lds + ML_U + (c * 64 + 32 * sblk + 8 * i4 + 4 * hh) * 4);
                f32x16 g;
#pragma unroll
                for (int i = 0; i < 16; ++i) g[i] = 0.f;
#pragma unroll
                for (int d0 = 0; d0 < 6; ++d0) g = __builtin_amdgcn_mfma_f32_32x32x16_bf16(kf[d0], qf[d0], g, 0, 0, 0);
#pragma unroll
                for (int i4 = 0; i4 < 4; ++i4) { const int s0 = 32 * sblk + 8 * i4 + 4 * hh;
#pragma unroll
                    for (int j = 0; j < 4; ++j) { const float e = __expf(us[i4][j] - Ml); g[4 * i4 + j] = (s0 + j <= lq) ? g[4 * i4 + j] * e : 0.f; } }
                *(LAS bf16x8*)dp = pack8(g, 0); *(LAS bf16x8*)(dp + 32) = pack8(g, 1);
            }
        } else if (wave == 4) { IW[ln] = __expf(mprev - MM[c * 64 + ln]); }
        ML_BAR();
        if (wave < 7) {
            bf16x8 vf[4];
            if (is_den) { vf[0] = ones; vf[1] = ones; vf[2] = ones; vf[3] = ones; }
            else {
#pragma unroll
                for (int ks = 0; ks < 4; ++ks) { LAS unsigned char* vb = lds + ML_V + (16 * ks + trow) * ML_VP + wave * 64 + tcol; vf[ks] = mk8(vtr(vb), vtr(vb + 8 * ML_VP)); } }
            bf16x8 qa[2][6], df[2][4]; f32x4 iw[2][4];
#pragma unroll
            for (int lblk = 0; lblk < 2; ++lblk) { LAS unsigned char* qrow = lds + ML_Q + (32 * lblk + r) * ML_QP + 8 * hh;
#pragma unroll
                for (int ks = 0; ks < 6; ++ks) { const v2u q0 = *(LAS v2u*)(qrow + ks * 32), q1 = *(LAS v2u*)(qrow + ks * 32 + 16); qa[lblk][ks] = __builtin_bit_cast(bf16x8, (v4u){q0.x, q0.y, q1.x, q1.y}); }
#pragma unroll
                for (int ks = 0; ks < 4; ++ks) df[lblk][ks] = *(LAS bf16x8*)(lds + ML_D + (32 * lblk + r) * ML_DP + (2 * ks + hh) * 16);
#pragma unroll
                for (int i4 = 0; i4 < 4; ++i4) iw[lblk][i4] = *(LAS f32x4*)(lds + ML_IW + (32 * lblk + 8 * i4 + 4 * hh) * 4); }
            bf16x8 cb[6];
#pragma unroll
            for (int kb = 0; kb < 3; ++kb) { cb[2 * kb] = pack8(Cacc[kb], 0); cb[2 * kb + 1] = pack8(Cacc[kb], 1); }
            f32x16 y0, y1;
#pragma unroll
            for (int i = 0; i < 16; ++i) { y0[i] = 0.f; y1[i] = 0.f; }
#pragma unroll
            for (int ks = 0; ks < 6; ++ks) { y0 = __builtin_amdgcn_mfma_f32_32x32x16_bf16(qa[0][ks], cb[ks], y0, 0, 0, 0); y1 = __builtin_amdgcn_mfma_f32_32x32x16_bf16(qa[1][ks], cb[ks], y1, 0, 0, 0); }
            bf16x8 kwf[3][4];
#pragma unroll
            for (int kb = 0; kb < 3; ++kb)
#pragma unroll
                for (int ks = 0; ks < 4; ++ks) { LAS unsigned char* kb_ = lds + ML_KW + (16 * ks + trow) * ML_KWP + kb * 64 + tcol; kwf[kb][ks] = mk8(vtr(kb_), vtr(kb_ + 8 * ML_KWP)); }
#pragma unroll
            for (int i4 = 0; i4 < 4; ++i4)
#pragma unroll
                for (int j = 0; j < 4; ++j) { y0[4 * i4 + j] *= iw[0][i4][j]; y1[4 * i4 + j] *= iw[1][i4][j]; }
#pragma unroll
            for (int ks = 0; ks < 4; ++ks) { y0 = __builtin_amdgcn_mfma_f32_32x32x16_bf16(df[0][ks], vf[ks], y0, 0, 0, 0); y1 = __builtin_amdgcn_mfma_f32_32x32x16_bf16(df[1][ks], vf[ks], y1, 0, 0, 0); }
            const float sp = __expf(mprev - mlast);
#pragma unroll
            for (int kb = 0; kb < 3; ++kb)
#pragma unroll
                for (int i = 0; i < 16; ++i) Cacc[kb][i] *= sp;
#pragma unroll
            for (int ks = 0; ks < 4; ++ks)
#pragma unroll
                for (int kb = 0; kb < 3; ++kb) Cacc[kb] = __builtin_amdgcn_mfma_f32_32x32x16_bf16(kwf[kb][ks], vf[ks], Cacc[kb], 0, 0, 0);
            if (!is_den) {
                unsigned* ht = (unsigned*)hf + ((((size_t)(dir * BATCH + b) * 4 + h) * 64 + c) * 6 + wave) * 1024 + ln;
#pragma unroll
                for (int p = 0; p < 8; ++p) { const int i = 4 * (p >> 1) + 2 * (p & 1); ht[p * 64] = cvtpk(y0[i], y0[i + 1]); ht[(8 + p) * 64] = cvtpk(y1[i], y1[i + 1]); }
            } else if (r == 0) {
                float* dl = dn + ((size_t)(dir * BATCH + b) * 4 + h) * SEQ + c * 64 + 4 * hh;
#pragma unroll
                for (int g = 0; g < 4; ++g) { f32x4 d0, d1;
#pragma unroll
                    for (int j = 0; j < 4; ++j) { const int tp0 = c * 64 + 8 * g + 4 * hh + j, tp1 = tp0 + 32;
                        d0[j] = fmaxf(fabsf(y0[4 * g + j]), __expf(-(BB[tp0] + MM[tp0]))); d1[j] = fmaxf(fabsf(y1[4 * g + j]), __expf(-(BB[tp1] + MM[tp1]))); }
                    *(GAS f32x4*)(dl + 8 * g) = d0; *(GAS f32x4*)(dl + 32 + 8 * g) = d1; }
            }
        }
        ML_BAR();
        if (c + 1 < 64) ml_store(st, lds, c + 1, t);
        ML_BAR();
    }
}
__device__ __forceinline__ void mlstm_phase(KArgs a, int l, LAS unsigned char* lds, int wave, int ln) {
    for (int job = blockIdx.x; job < 64; job += gridDim.x) mlstm_job(a, l, lds, job, wave, ln);
    __syncthreads();
}

constexpr int PH_PER_LAYER = 11, N_PHASES = 1 + DEPTH * PH_PER_LAYER;
#ifndef MK_N_LAUNCHES
#define MK_N_LAUNCHES 1
#endif
#define lane (lane_id())
#define tid (wave * 64 + lane)
#define gw ((int)blockIdx.x * NWAVES + wave)
#define wsp() (kargs()->ws)
#define x_in ((const float*)kargs()->in[0])
#define xres ((bf16*)(wsp() + WS_XR))
#define HB ((bf16*)(wsp() + WS_HBUF))
#define YB ((bf16*)(wsp() + WS_YBUF))
#define YC ((bf16*)(wsp() + WS_YCAT))
#define PJ ((bf16*)(wsp() + WS_PROJ))
#define QM ((bf16*)(wsp() + WS_QMLA))
#define KVM ((bf16*)(wsp() + WS_KVMLA))
#define AB ((bf16*)(wsp() + WS_ABUF))
#define modp ((const float*)(wsp() + WS_MOD))
#define IN(k) (lo <= (k) && (k) < hi)
#define SEAM(k) do { if (IN(k) && IN((k) + 1)) xcd_barrier<false>(bar, tid == 0); } while (0)
#define SEAM0(k) do { if (IN(k) && IN((k) + 1)) xcd_barrier<true>(bar, tid == 0); } while (0)

template <int l> __device__ __forceinline__ void layer_phases(LAS unsigned char* lds, const XcdBarrier& bar, const int wave, const int lo, const int hi) {
    const int G = gridDim.x, NGW = G * NWAVES;
    constexpr int pb = 1 + l * PH_PER_LAYER;
#define wb (wsp() + WS_W + (size_t)l * W_LAYER)
#define modl (modp + (size_t)l * BATCH * NMOD)
    if (l == 0 && IN(pb + 0)) {
        const float* g = (const float*)kargs()->in[5] + l * DM; const int ln = lane;
        for (int r0 = blockIdx.x * 128; r0 < M; r0 += G * 128) { const int b = r0 / SEQ; const float* mb = modl + (size_t)b * NMOD;
            row_norm_wg<true, false, false, false, true>(lds, x_in, nullptr, nullptr, nullptr, nullptr, HB, g, mb + 1 * DM, mb + 0 * DM, r0, wave, ln); }
    }
    SEAM(pb + 0);
    if (IN(pb + 1)) {
        pg8::Gemm g{HB, (const bf16*)(wb + WO_IN), M, NINP, DM, DM}; pg8::StaticOrder S; S.init(M, NINP, G, (int)blockIdx.x);
        pg8::EpiBf16 E{PJ, NINP};
        pg8::gemm_phase<pg8::EpiBf16, pg8::StaticOrder, false, true>(lds + RING_OFF, g, S, E, wave);
    }
    SEAM(pb + 1);
    if (IN(pb + 2)) prep_rows(kargs(), wave, lane);
    SEAM(pb + 2);
    if (IN(pb + 3)) {
        { pg8::Gemm g{PJ + C_BCQ, (const bf16*)(wb + WO_UQ), M, NQB, QLP, NINP}; pg8::StaticOrder S; S.init(M, NQB, G, (int)blockIdx.x);
          pg8::EpiQRope E{QM, NQB, (const float*)(wsp() + WS_RSQ), QSCALE_B, (const float*)(wsp() + WS_COS), (const float*)(wsp() + WS_SIN)};
          pg8::gemm_phase<pg8::EpiQRope, pg8::StaticOrder, false, true>(lds + RING_OFF, g, S, E, wave); }
        __syncthreads();
        { pg8::Gemm g{PJ + C_BCKV, (const bf16*)(wb + WO_UKV), M, NKVB, KVL, NINP}; pg8::SubOrder S; const int GH = G / 2, cb = (int)blockIdx.x;
          if (cb < GH) S.init(M, NKVB, GH, cb, 0, 1); else S.init(M, NKVB, GH, cb - GH, GH, 3);
          pg8::EpiRowScale E{KVM, NKVB, (const float*)(wsp() + WS_RSKV), 1.0f};
          pg8::gemm_phase<pg8::EpiRowScale, pg8::SubOrder, false, true>(lds + RING_OFF, g, S, E, wave); }
    }
    SEAM(pb + 3);
    if (IN(pb + 4)) {
        __syncthreads();
        const int xl = blockIdx.x & 7; unsigned* qh = (unsigned*)(wsp() + WS_CTL) + CW_Q + 64 * (l * 8 + xl);
        volatile LAS unsigned* qw = (volatile LAS unsigned*)(lds + MISC_OFF) + 16;
        const bool t0 = (tid == 0);
        if (t0) qw[0] = __hip_atomic_fetch_add(qh, 1u, __ATOMIC_RELAXED, __HIP_MEMORY_SCOPE_AGENT);
        __syncthreads();
        for (;;) {
            const unsigned it = qw[0];
            if (it >= 264u) break;
            unsigned nxt = 0u; if (t0) nxt = __hip_atomic_fetch_add(qh, 1u, __ATOMIC_RELAXED, __HIP_MEMORY_SCOPE_AGENT);
            if (it < 8u) mlstm_job(kargs(), l, lds, xl * 8 + (int)it, wave, lane);
            else if (it < 72u) { const int v = (int)it - 8, bh = xl * 4 + (v >> 4), qb = v & 15;
                __syncthreads();
                mla_unit((const bf16*)(wsp() + WS_QMLA), (const bf16*)(wsp() + WS_KVMLA), (const bf16*)(wsp() + WS_KROPE), (bf16*)(wsp() + WS_YCAT), lds, bh >> 2, bh & 3, qb, wave, lane); }
            else if (it >= 264u) { const int ch = ((int)it - 264) * 8 + xl; __syncthreads(); if (ch < NDEF_CHUNKS) convert_deferred_chunk(kargs(), lds, ch, wave, lane); }
            else { const int v = (int)it - 72, u = xl * 192 + v, qb = u & 15, hq = (u >> 4) % 12, b = u / 192; const float* sink = (const float*)kargs()->in[10] + l * 12;
                win_unit((const bf16*)(wsp() + WS_PROJ), (bf16*)(wsp() + WS_YCAT), sink[hq] * LOG2E, ALIBI[hq] * LOG2E, lds, b, hq, qb, wave, lane); }
            __syncthreads();
            if (t0) qw[0] = nxt;
            __syncthreads();
        }
    }
    SEAM(pb + 4);
    if (IN(pb + 5)) mlstm_combine(kargs(), l, wave, lane);
    SEAM(pb + 5);
    if (IN(pb + 6)) {
        pg8::Gemm g{YC, (const bf16*)(wb + WO_OUT), M, DM, DM, DM}; pg8::StaticOrder S; S.init(M, DM, G, (int)blockIdx.x);
        pg8::EpiBf16 E{YB, DM};
        pg8::gemm_phase<pg8::EpiBf16, pg8::StaticOrder, false, true>(lds + RING_OFF, g, S, E, wave);
    }
    SEAM(pb + 6);
    if (IN(pb + 7)) {
        const float* gp = (const float*)kargs()->in[6] + l * DM; const float* g2 = (const float*)kargs()->in[7] + l * DM; const int ln = lane;
        for (int r0 = blockIdx.x * 128; r0 < M; r0 += G * 128) { const int b = r0 / SEQ; const float* mb = modl + (size_t)b * NMOD;
            if (l == 0) row_norm_wg<true, false, true, true, true>(lds, x_in, YB, mb + 2 * DM, gp, xres, HB, g2, mb + 4 * DM, mb + 3 * DM, r0, wave, ln);
            else row_norm_wg<false, false, true, true, true>(lds, xres, YB, mb + 2 * DM, gp, xres, HB, g2, mb + 4 * DM, mb + 3 * DM, r0, wave, ln); }
    }
    SEAM(pb + 7);
    if (IN(pb + 8)) {
        pg8::Gemm g{HB, (const bf16*)(wb + WO_GU), M, 2 * DFF, DM, DM}; pg8::StaticOrder S; S.init(M, 2 * DFF, G, (int)blockIdx.x);
        pg8::EpiSwiGLU E{AB, DFF};
        pg8::gemm_phase<pg8::EpiSwiGLU, pg8::StaticOrder, false, true>(lds + RING_OFF, g, S, E, wave);
    }
    SEAM(pb + 8);
    if (IN(pb + 9)) {
        pg8::Gemm g{AB, (const bf16*)(wb + WO_DN), M, DM, DFF, DFF}; pg8::StaticOrder S; S.init(M, DM, G, (int)blockIdx.x);
        pg8::EpiBf16 E{YB, DM};
        pg8::gemm_phase<pg8::EpiBf16, pg8::StaticOrder, false, true>(lds + RING_OFF, g, S, E, wave);
    }
    SEAM(pb + 9);
    if (IN(pb + 10)) {
        constexpr bool nxt = (l + 1 < DEPTH); constexpr int ln1 = nxt ? l + 1 : l;
        const float* gp = (const float*)kargs()->in[8] + l * DM; const float* g1n = (const float*)kargs()->in[5] + ln1 * DM; const float* modn = modp + (size_t)ln1 * BATCH * NMOD; const int ln = lane;
        for (int r0 = blockIdx.x * 128; r0 < M; r0 += G * 128) { const int b = r0 / SEQ; const float* mb = modl + (size_t)b * NMOD; const float* mbn = modn + (size_t)b * NMOD;
            if (nxt) row_norm_wg<false, false, true, true, true>(lds, xres, YB, mb + 5 * DM, gp, xres, HB, g1n, mbn + 1 * DM, mbn + 0 * DM, r0, wave, ln);
            else row_norm_wg<false, true, true, true, false>(lds, xres, YB, mb + 5 * DM, gp, kargs()->out, nullptr, nullptr, nullptr, nullptr, r0, wave, ln); }
    }
    if (l + 1 < DEPTH) SEAM(pb + 10);
#undef wb
#undef modl
}

__global__ void __launch_bounds__(NTHR, 2) fwd_kernel(Args args) {
    extern __shared__ __attribute__((aligned(16))) unsigned char lds_raw[];
    LAS unsigned char* lds = (LAS unsigned char*)lds_raw;
    volatile LAS unsigned* MISC = (volatile LAS unsigned*)(lds + MISC_OFF);
    const int wave = __builtin_amdgcn_readfirstlane((int)threadIdx.x >> 6);
    unsigned* ctl = (unsigned*)(kargs()->ws + WS_CTL);
    for (int u = (int)threadIdx.x; u < (LDS_BYTES - LDSCTL_OFF) / 4; u += NTHR) ((LAS unsigned*)(lds + LDSCTL_OFF))[u] = 0u;
    __syncthreads();
    XcdBarrier bar; bar.bar = ctl + CW_BAR; bar.x = 0; bar.st = nullptr;
#if MK_N_LAUNCHES == 1 && !defined(PROBE_LIST)
    constexpr int lo = 0, hi = N_PHASES;
#else
    const int lo = kargs()->ph_lo, hi = kargs()->ph_hi;
#endif
    if (hi - lo > 1) bar = xcd_barrier_post(ctl + CW_BAR, MISC + 8, tid == 0);
#ifdef PROBE_LIST
    if (lo >= 100) {
        if (lo == 100) mlstm_phase(kargs(), 0, lds, wave, lane);
        else if (lo == 101) mla_phase(kargs(), lds, wave, lane);
        else if (lo == 102) win_phase(kargs(), 0, lds, wave, lane);
        else if (lo == 103) p0_prologue<1>(kargs(), lds, wave, lane, tid);
        else if (lo == 104) p0_prologue<2>(kargs(), lds, wave, lane, tid);
        else if (lo == 105) p0_prologue<4>(kargs(), lds, wave, lane, tid);
        return;
    }
#endif
    if (IN(0)) { p0_prologue<7>(kargs(), lds, wave, lane, tid); }
    SEAM0(0);
    layer_phases<0>(lds, bar, wave, lo, hi);
    layer_phases<1>(lds, bar, wave, lo, hi);
}
#undef IN
#undef SEAM
#undef SEAM0
#undef lane
#undef tid
#undef gw

extern "C" void kernel_launch(void* const* d_in, const int* in_sizes, int n_in, void* d_out, int out_size, void* d_ws, size_t ws_size, hipStream_t stream) {
    static int grid = 0;
    if (grid == 0) {
        if (n_in != 21 || in_sizes[0] != M * DM || out_size != M * DM || ws_size < WS_END) { fprintf(stderr, "kernel_launch: unexpected shapes/workspace (n_in %d, in0 %d, out %d, ws %zu, need %zu)\n", n_in, n_in > 0 ? in_sizes[0] : -1, out_size, ws_size, (size_t)WS_END); grid = -1; return; }
        int dev = 0, cus = 0, per_cu = 0;
        if (hipGetDevice(&dev) != hipSuccess || hipDeviceGetAttribute(&cus, hipDeviceAttributeMultiprocessorCount, dev) != hipSuccess) { grid = -1; return; }
        if (hipFuncSetAttribute((const void*)fwd_kernel, hipFuncAttributeMaxDynamicSharedMemorySize, LDS_BYTES) != hipSuccess) { fprintf(stderr, "kernel_launch: hipFuncSetAttribute failed\n"); grid = -1; return; }
        if (hipOccupancyMaxActiveBlocksPerMultiprocessor(&per_cu, (const void*)fwd_kernel, NTHR, LDS_BYTES) != hipSuccess || per_cu < 1) fprintf(stderr, "kernel_launch: occupancy query reports %d\n", per_cu);
        (void)hipGetLastError();
        grid = cus;
    }
    if (grid < 0) return;
    (void)hipMemsetAsync((char*)d_ws + WS_CTL, 0, CTL_ZERO_BYTES, stream);
    Args a{};
    for (int i = 0; i < 21; ++i) a.in[i] = d_in[i];
    a.out = (float*)d_out; a.ws = (unsigned char*)d_ws;
    if (MK_N_LAUNCHES == 1) { a.ph_lo = 0; a.ph_hi = N_PHASES; hipLaunchKernelGGL(fwd_kernel, dim3(grid), dim3(NTHR), LDS_BYTES, stream, a);
#ifdef PROBE_LIST
        { const int pl[] = {PROBE_LIST}; for (int p : pl) { a.ph_lo = p; a.ph_hi = p + 1; hipLaunchKernelGGL(fwd_kernel, dim3(grid), dim3(NTHR), LDS_BYTES, stream, a); } }
#endif
    }
    else { for (int p = 0; p < N_PHASES; ++p) { a.ph_lo = p; a.ph_hi = p + 1; hipLaunchKernelGGL(fwd_kernel, dim3(grid), dim3(NTHR), LDS_BYTES, stream, a); } }
}
```
